# Optimizing an MI355X kernel written in HIP

```python
import jax, jax.numpy as jnp
from jax import lax
import numpy as np

D_MODEL = 1024
BATCH = 2
SEQ = 8192
DEPTH = 4

N_MIXERS = 2
N_LRU_LAYERS = (DEPTH + 1) // 2
N_POOL_LAYERS = DEPTH // 2
D_FF = 11 * D_MODEL // 4
D_RNN = 5 * D_MODEL // 4
LRU_HEADS = 16
LRU_HEAD_DIM = D_RNN // LRU_HEADS
CONV_WIDTH = 4
LRU_C = 8.0
POOL_WINDOWS = (2, 4, 8, 16)
POOL_GROUPS = len(POOL_WINDOWS)
POOL_GROUP_DIM = D_MODEL // POOL_GROUPS
PLE_DIM = 256
RMS_EPS = 1e-6

kernel_name = "hybrid_rglru_pool_macaron_ple"


def rms_norm(x, g):
    xf = x.astype(jnp.float32)
    y = xf * lax.rsqrt(jnp.mean(xf * xf, axis=-1, keepdims=True) + RMS_EPS)
    return (y * g.astype(jnp.float32)).astype(x.dtype)


def swiglu(x, w_gate, w_up, w_down):
    return (jax.nn.silu(x @ w_gate) * (x @ w_up)) @ w_down


def _lin_combine(c1, c2):
    a1, b1 = c1
    a2, b2 = c2
    return a1 * a2, a2 * b1 + b2


def rglru_mixer(x, w_in, conv_w, conv_b, w_a, b_a, w_x, b_x, a_param, w_out):
    B, S, _ = x.shape
    z = x @ w_in
    gate_branch, xb = z[..., :D_RNN], z[..., D_RNN:]
    xp = jnp.pad(xb, ((0, 0), (CONV_WIDTH - 1, 0), (0, 0)))
    xc = conv_b + conv_w[0] * xp[:, 0:S]
    for k in range(1, CONV_WIDTH):
        xc = xc + conv_w[k] * xp[:, k:k + S]
    xh = xc.reshape(B, S, LRU_HEADS, LRU_HEAD_DIM)
    r = jax.nn.sigmoid(jnp.einsum('bshi,hij->bshj', xh, w_a).reshape(B, S, D_RNN) + b_a)
    ig = jax.nn.sigmoid(jnp.einsum('bshi,hij->bshj', xh, w_x).reshape(B, S, D_RNN) + b_x)
    log_a = -LRU_C * r.astype(jnp.float32) * jax.nn.softplus(-a_param.astype(jnp.float32))
    a = jnp.exp(log_a)
    mult = jnp.sqrt(-jnp.expm1(2.0 * log_a))
    bterm = mult * (ig * xc).astype(jnp.float32)
    _, h = lax.associative_scan(_lin_combine, (a, bterm), axis=1)
    y = h.astype(x.dtype) * jax.nn.gelu(gate_branch)
    return y @ w_out


def pool_mixer(x, w, b, scale):
    B, S, _ = x.shape
    xf = x.astype(jnp.float32)
    cs = jnp.cumsum(xf, axis=1)
    t = jnp.arange(S)
    outs = []
    for g, win in enumerate(POOL_WINDOWS):
        lo, hi = g * POOL_GROUP_DIM, (g + 1) * POOL_GROUP_DIM
        c = cs[..., lo:hi]
        prev = jnp.pad(c[:, :S - win], ((0, 0), (win, 0), (0, 0)))
        count = jnp.minimum(t + 1, win).astype(jnp.float32)[None, :, None]
        outs.append((c - prev) / count - xf[..., lo:hi])
    u = jnp.stack(outs, axis=2).astype(x.dtype)
    y = jnp.einsum('bsgc,gcd->bsgd', u, w).reshape(B, S, D_MODEL)
    return (y + b) * scale


def setup_inputs(seed: int = 0) -> dict:
    key = jax.random.key(seed)
    ks = iter(jax.random.split(key, 40))

    def nrm(shape, scale):
        return scale * jax.random.normal(next(ks), shape, jnp.float32)

    D, F, L = D_MODEL, D_FF, DEPTH
    NL, NP = N_LRU_LAYERS, N_POOL_LAYERS
    x = nrm((BATCH, SEQ, D), 1.0)
    p = nrm((DEPTH, BATCH, SEQ, PLE_DIM), 1.0)
    ffn1_norm = 1.0 + nrm((L, D), 0.1)
    ffn1_w_gate = nrm((L, D, F), D ** -0.5)
    ffn1_w_up = nrm((L, D, F), D ** -0.5)
    ffn1_w_down = nrm((L, F, D), F ** -0.5)
    mix_norm = 1.0 + nrm((L, D), 0.1)
    lru_w_in = nrm((NL, D, 2 * D_RNN), D ** -0.5)
    lru_conv_w = nrm((NL, CONV_WIDTH, D_RNN), CONV_WIDTH ** -0.5)
    lru_conv_b = nrm((NL, D_RNN), 0.01)
    lru_w_a = nrm((NL, LRU_HEADS, LRU_HEAD_DIM, LRU_HEAD_DIM), LRU_HEAD_DIM ** -0.5)
    lru_b_a = nrm((NL, D_RNN), 0.01)
    lru_w_x = nrm((NL, LRU_HEADS, LRU_HEAD_DIM, LRU_HEAD_DIM), LRU_HEAD_DIM ** -0.5)
    lru_b_x = nrm((NL, D_RNN), 0.01)
    u = jax.random.uniform(next(ks), (NL, D_RNN), jnp.float32, minval=0.9, maxval=0.999)
    a0 = u ** (1.0 / LRU_C)
    lru_a_param = jnp.log(a0) - jnp.log1p(-a0)
    lru_w_out = nrm((NL, D_RNN, D), D_RNN ** -0.5)
    pool_w = nrm((NP, POOL_GROUPS, POOL_GROUP_DIM, POOL_GROUP_DIM), POOL_GROUP_DIM ** -0.5)
    pool_b = nrm((NP, D), 0.01)
    pool_scale = 1.0 + nrm((NP, D), 0.1)
    ffn2_norm = 1.0 + nrm((L, D), 0.1)
    ffn2_w_gate = nrm((L, D, F), D ** -0.5)
    ffn2_w_up = nrm((L, D, F), D ** -0.5)
    ffn2_w_down = nrm((L, F, D), F ** -0.5)
    ple_norm = 1.0 + nrm((L, D), 0.1)
    ple_w_gate = nrm((L, D, D), D ** -0.5)
    ple_w_proj = nrm((L, PLE_DIM, D), PLE_DIM ** -0.5)
    final_norm = 1.0 + nrm((D,), 0.1)
    return {"x": x, "p": p,
            "ffn1_norm": ffn1_norm, "ffn1_w_gate": ffn1_w_gate, "ffn1_w_up": ffn1_w_up, "ffn1_w_down": ffn1_w_down,
            "mix_norm": mix_norm,
            "lru_w_in": lru_w_in, "lru_conv_w": lru_conv_w, "lru_conv_b": lru_conv_b,
            "lru_w_a": lru_w_a, "lru_b_a": lru_b_a, "lru_w_x": lru_w_x, "lru_b_x": lru_b_x,
            "lru_a_param": lru_a_param, "lru_w_out": lru_w_out,
            "pool_w": pool_w, "pool_b": pool_b, "pool_scale": pool_scale,
            "ffn2_norm": ffn2_norm, "ffn2_w_gate": ffn2_w_gate, "ffn2_w_up": ffn2_w_up, "ffn2_w_down": ffn2_w_down,
            "ple_norm": ple_norm, "ple_w_gate": ple_w_gate, "ple_w_proj": ple_w_proj,
            "final_norm": final_norm}


def reference(x, p, ffn1_norm, ffn1_w_gate, ffn1_w_up, ffn1_w_down, mix_norm,
              lru_w_in, lru_conv_w, lru_conv_b, lru_w_a, lru_b_a, lru_w_x, lru_b_x, lru_a_param, lru_w_out,
              pool_w, pool_b, pool_scale,
              ffn2_norm, ffn2_w_gate, ffn2_w_up, ffn2_w_down,
              ple_norm, ple_w_gate, ple_w_proj, final_norm):
    h = x
    for i in range(DEPTH):
        h = h + 0.5 * swiglu(rms_norm(h, ffn1_norm[i]), ffn1_w_gate[i], ffn1_w_up[i], ffn1_w_down[i])
        hn = rms_norm(h, mix_norm[i])
        j = i // N_MIXERS
        if i % N_MIXERS == 0:
            m = rglru_mixer(hn, lru_w_in[j], lru_conv_w[j], lru_conv_b[j], lru_w_a[j], lru_b_a[j],
                            lru_w_x[j], lru_b_x[j], lru_a_param[j], lru_w_out[j])
        else:
            m = pool_mixer(hn, pool_w[j], pool_b[j], pool_scale[j])
        h = h + m
        h = h + 0.5 * swiglu(rms_norm(h, ffn2_norm[i]), ffn2_w_gate[i], ffn2_w_up[i], ffn2_w_down[i])
        gate = jax.nn.sigmoid(rms_norm(h, ple_norm[i]) @ ple_w_gate[i])
        h = h + gate * (p[i].astype(h.dtype) @ ple_w_proj[i])
    return rms_norm(h, final_norm)
```

```cpp
#include <hip/hip_runtime.h>
#include <hip/hip_cooperative_groups.h>
#include <cstdio>
namespace cg = cooperative_groups;

#ifndef ONE_LAUNCH
#define ONE_LAUNCH 1
#endif

#define LAS __attribute__((address_space(3)))
typedef unsigned short bf16_t;
typedef short bf16x8 __attribute__((ext_vector_type(8)));
typedef float f32x4 __attribute__((ext_vector_type(4)));
typedef float f32x2 __attribute__((ext_vector_type(2)));
typedef unsigned u32x4 __attribute__((ext_vector_type(4)));
typedef unsigned u32x2 __attribute__((ext_vector_type(2)));

constexpr int M_ = 16384, D_ = 1024, F_ = 2816, R_ = 1280, S_ = 8192, PLE_ = 256;
constexpr float EPS_ = 1e-6f;
constexpr int NTHR = 512, NWAVES = 8;

constexpr size_t OFF_CTL = 0;
constexpr size_t OFF_SS  = 16384;
constexpr size_t SS_STRIDE = (size_t)M_;
constexpr size_t OFF_AGG = OFF_SS + 17 * SS_STRIDE * 4;
constexpr size_t AGG_ELEMS = (size_t)2 * 128 * R_;
constexpr size_t OFF_WL0 = OFF_AGG + 2 * AGG_ELEMS * 4;
constexpr size_t WL_GU1 = 0;
constexpr size_t WL_D1  = WL_GU1 + (size_t)2 * F_ * D_ * 2;
constexpr size_t WL_GU2 = WL_D1 + (size_t)D_ * F_ * 2;
constexpr size_t WL_D2  = WL_GU2 + (size_t)2 * F_ * D_ * 2;
constexpr size_t WL_MIX = WL_D2 + (size_t)D_ * F_ * 2;
constexpr size_t WL_WIN = WL_MIX;
constexpr size_t WL_WG  = WL_WIN + (size_t)2 * R_ * D_ * 2;
constexpr size_t WL_WOUT = WL_WG + (size_t)2 * R_ * R_ * 2;
constexpr size_t WL_PG  = WL_WOUT + (size_t)D_ * R_ * 2;
constexpr size_t WL_PP  = WL_PG + (size_t)D_ * D_ * 2;
constexpr size_t WL_PB  = WL_PP + (size_t)D_ * PLE_ * 2;
constexpr size_t WL_SIZE = WL_PB + (size_t)M_ * PLE_ * 2;
constexpr size_t OFF_WL1 = OFF_WL0 + WL_SIZE;
constexpr size_t OFF_HB0 = OFF_WL1 + WL_SIZE;
constexpr size_t OFF_R1  = OFF_HB0 + (size_t)M_ * D_ * 2;
constexpr size_t OFF_R2  = OFF_R1 + (size_t)M_ * F_ * 2;
constexpr size_t OFF_R4  = OFF_R2 + (size_t)M_ * R_ * 4;
constexpr size_t OFF_R5  = OFF_R4 + (size_t)M_ * R_ * 2;
constexpr size_t WS_END  = OFF_R5 + (size_t)M_ * R_ * 2;
static_assert(OFF_WL0 % 256 == 0 && WL_SIZE % 256 == 0, "align");

constexpr int LDS_STAGE = 131072;
constexpr int LDS_PL = LDS_STAGE + 64, LDS_DL = LDS_PL + 256, DESC_BYTES = 144, LDS_BYTES = LDS_DL + 40 * DESC_BYTES;

struct Params {
    const float* in[27];
    float* out;
    unsigned char* ws;
    int lo, hi;
};
enum { I_X = 0, I_P, I_F1N, I_F1G, I_F1U, I_F1D, I_MIXN, I_LWIN, I_LCW, I_LCB, I_LWA, I_LBA, I_LWX, I_LBX, I_LAP, I_LWOUT,
       I_PW, I_PB, I_PS, I_F2N, I_F2G, I_F2U, I_F2D, I_PLN, I_PLG, I_PLP, I_FN };

__device__ __forceinline__ unsigned pk2(float lo, float hi) { unsigned r; asm volatile("v_cvt_pk_bf16_f32 %0, %1, %2" : "=v"(r) : "v"(lo), "v"(hi)); return r; }
__device__ __forceinline__ float bf_lo(unsigned w) { return __uint_as_float(w << 16); }
__device__ __forceinline__ float bf_hi(unsigned w) { return __uint_as_float(w & 0xffff0000u); }
__device__ __forceinline__ float fsigmoid(float x) { return __builtin_amdgcn_rcpf(1.0f + __expf(-x)); }
__device__ __forceinline__ float wave_sum(float v) {
#pragma unroll
    for (int o = 1; o < 64; o <<= 1) v += __shfl_xor(v, o);
    return v;
}
__device__ __forceinline__ int opaque_tid() { int t = threadIdx.x; asm volatile("" : "+v"(t)); return t; }
__device__ __forceinline__ int opaque_bid() { int b = blockIdx.x; asm volatile("" : "+s"(b)); return b; }
__device__ __forceinline__ int opaque_s(int v) { v = __builtin_amdgcn_readfirstlane(v); asm volatile("" : "+s"(v)); return v; }
#define LDS_WAIT() asm volatile("s_waitcnt lgkmcnt(0)" ::: "memory")

#define XB_TMO      128
#define XB_XCNT(j)  (256  + 64 * (j))
#define XB_XSUB(j)  (1280 + 64 * (j))
#define XB_XGEN(j)  (2304 + 64 * (j))
#define XB_TOP      3328
#define XB_TOPGEN   3392
#define XCD_BAR_WORDS 3456
#define XB_SPIN_CAP (1u << 22)
__device__ __forceinline__ unsigned xb_ld(unsigned* p)              { return __hip_atomic_load(p, __ATOMIC_RELAXED, __HIP_MEMORY_SCOPE_AGENT); }
__device__ __forceinline__ unsigned xb_add(unsigned* p, unsigned v) { return __hip_atomic_fetch_add(p, v, __ATOMIC_RELAXED, __HIP_MEMORY_SCOPE_AGENT); }
__device__ __forceinline__ unsigned xb_xcc_id() { return (unsigned)__builtin_amdgcn_s_getreg((3 << 11) | 20) & 0xFu; }
#define XB_SPIN(cond, bar) do { unsigned _sp = 0; while (cond) { __builtin_amdgcn_s_sleep(1); \
    if ((++_sp & 255u) == 0u) { if (xb_ld(&(bar)[XB_TMO])) break; if (_sp > XB_SPIN_CAP) { atomicAdd(&(bar)[XB_TMO], 1u); break; } } } } while (0)
__device__ __forceinline__ void xcd_barrier_post(unsigned* bar, volatile LAS unsigned* st) {
    if (threadIdx.x == 0) { const unsigned x = xb_xcc_id(); st[2] = x; *(volatile LAS unsigned long long*)(st + 4) = (unsigned long long)bar; (void)xb_add(&bar[XB_XCNT(x)], 1u); }
}
__device__ __forceinline__ void xcd_barrier_complete(unsigned* bar, unsigned x, unsigned& nloc, unsigned& nx) {
    const unsigned G = gridDim.x * gridDim.y * gridDim.z;
    unsigned sum, cnt, mine, sp = 0u;
    for (;;) {
        sum = 0u; cnt = 0u;
        for (unsigned j = 0; j < 16; ++j) { const unsigned c = xb_ld(&bar[XB_XCNT(j)]); sum += c; cnt += (c > 0u) ? 1u : 0u; }
        mine = xb_ld(&bar[XB_XCNT(x)]);
        if (sum == G) break;
        __builtin_amdgcn_s_sleep(1);
        if ((++sp & 255u) == 0u) { if (xb_ld(&bar[XB_TMO])) break; if (sp > XB_SPIN_CAP) { atomicAdd(&bar[XB_TMO], 1u); break; } }
    }
    nloc = mine > 0u ? mine : 1u; nx = cnt > 0u ? cnt : 1u;
}
__device__ __forceinline__ void xcd_barrier(volatile LAS unsigned* st) {
    asm volatile("s_waitcnt vmcnt(0)" ::: "memory");
    __syncthreads();
    if (opaque_tid() == 0) {
        unsigned* bar = (unsigned*)(*(volatile LAS unsigned long long*)(st + 4));
        const unsigned x = st[2];
        __builtin_amdgcn_s_waitcnt(0);
        unsigned nloc = st[0], nx = st[1];
        if (nloc == 0u) { xcd_barrier_complete(bar, x, nloc, nx); st[0] = nloc; st[1] = nx; }
        const unsigned old = xb_add(&bar[XB_XSUB(x)], 1u);
        const unsigned gen = old / nloc;
        if (old + 1u == (gen + 1u) * nloc) {
            __builtin_amdgcn_fence(__ATOMIC_RELEASE, "agent");
            asm volatile("s_waitcnt vmcnt(0)" ::: "memory");
            const unsigned og = xb_add(&bar[XB_TOP], 1u);
            const unsigned tg = og / nx;
            if (og + 1u == (tg + 1u) * nx) xb_add(&bar[XB_TOPGEN], 1u);
            else XB_SPIN(xb_ld(&bar[XB_TOPGEN]) == tg, bar);
            __builtin_amdgcn_fence(__ATOMIC_ACQUIRE, "agent");
            xb_add(&bar[XB_XGEN(x)], 1u);
            asm volatile("s_waitcnt vmcnt(0)" ::: "memory");
        } else {
            XB_SPIN(xb_ld(&bar[XB_XGEN(x)]) == gen, bar);
            __builtin_amdgcn_fence(__ATOMIC_ACQUIRE, "agent");
            asm volatile("s_waitcnt vmcnt(0)" ::: "memory");
        }
    }
    __syncthreads();
}

constexpr int BM = 256, BK = 64, HALF = 128, HTB = HALF * BK * 2, NXCD = 8, WGM = 8;
__device__ __forceinline__ int lds_byte(int r, int c) { const int st = (r >> 4) * 2 + (c >> 5), rr = r & 15, cc = c & 31, ob = rr * 64 + cc * 2; return st * 1024 + (ob ^ (((ob >> 9) & 1) << 5)); }
__device__ __forceinline__ void stage_rc(int b, int& R, int& C) { const int st = b / 1024, sb = b % 1024, swz = sb ^ (((sb >> 9) & 1) << 5); R = (st >> 1) * 16 + swz / 64; C = (st & 1) * 32 + (swz % 64) / 2; }

enum { E_GU = 0, E_RESID = 1, E_WIN = 2, E_GATES = 3, E_PROJ = 4 };
struct GemmDesc {
    const bf16_t* A; const bf16_t* Bt;
    int lda, ldb, nM, nN, nt, kmode;
    int emode, sub;
    float alpha;
    const float* ss;
    bf16_t* o16;
    float* o32;
    const float* hsrc;
    float* ssn;
    const float* v0; const float* v1; const float* v2;
    const bf16_t* pp;
    float* xcb;
    int op, layer;
};
struct Unit { int pm, pn, nt; const char* cA; const char* cB; };

__device__ __forceinline__ int rfl(int v) { return __builtin_amdgcn_readfirstlane(v); }
__device__ __forceinline__ const char* rfl_ptr(const char* p) { const unsigned long long u = (unsigned long long)p; const unsigned lo = (unsigned)__builtin_amdgcn_readfirstlane((int)(unsigned)u), hi = (unsigned)__builtin_amdgcn_readfirstlane((int)(unsigned)(u >> 32)); return (const char*)(((unsigned long long)hi << 32) | lo); }
typedef const LAS GemmDesc* DescP;
__device__ __forceinline__ DescP opaque_desc(int daddr) { unsigned a = (unsigned)daddr; asm volatile("" : "+v"(a)); return (DescP)a; }
__device__ __forceinline__ bool unit_next(int daddr, int i, int G, int c, Unit& u) {
    DescP d = opaque_desc(daddr);
    const int nM = rfl(d->nM), nN = rfl(d->nN), nwg = nM * nN;
    const long L = (long)i * G + c; if (L >= nwg) return false;
    int wgid = (int)L; { const int q = nwg / NXCD, r = nwg % NXCD, xcd = wgid % NXCD, off = wgid / NXCD; wgid = (xcd < r ? xcd * (q + 1) : r * (q + 1) + (xcd - r) * q) + off; }
    const int nig = WGM * nN, gid = wgid / nig, fm = gid * WGM, gsz = (nM - fm) < WGM ? (nM - fm) : WGM;
    u.pm = fm + ((wgid % nig) % gsz); u.pn = (wgid % nig) / gsz;
    const int kmode = rfl(d->kmode), lda = rfl(d->lda), ldb = rfl(d->ldb);
    int koffA = 0, koffB = 0, nt = rfl(d->nt);
    if (kmode == 1) { koffA = u.pn * 256; }
    else if (kmode == 2) {
        const int c0 = u.pn * 128, h0 = c0 / 80, h1 = (c0 + 127) / 80;
        int k0 = (h0 * 80) & ~127; int k1 = ((h1 + 1) * 80 + 127) & ~127; if (k1 > R_) k1 = R_;
        koffA = k0; koffB = k0; nt = (k1 - k0) / 64;
    }
    u.nt = nt;
    u.cA = rfl_ptr((const char*)d->A + ((size_t)u.pm * 256 * lda + koffA) * 2);
    u.cB = rfl_ptr((const char*)d->Bt + ((size_t)u.pn * 256 * ldb + koffB) * 2);
    return true;
}

__device__ __forceinline__ float gelu_tanh(float x) { const float t = x + 0.044715f * x * x * x; return x * __builtin_amdgcn_rcpf(1.0f + __expf(-1.5957691216f * t)); }

__device__ __forceinline__ void epilogue(int daddr, f32x4 (&acc)[2][2][4][2], int pm, int pn, int wr, int wc, int fr, int fq) {
    DescP dl = opaque_desc(daddr);
    GemmDesc d; d.emode = rfl(dl->emode); d.sub = rfl(dl->sub); d.alpha = dl->alpha; d.ss = dl->ss; d.o16 = dl->o16; d.o32 = dl->o32; d.hsrc = dl->hsrc; d.ssn = dl->ssn; d.v0 = dl->v0; d.v1 = dl->v1; d.v2 = dl->v2; d.pp = dl->pp; d.xcb = dl->xcb;
    const int row0 = pm * BM + wr * 64 + fr;
    const int cw = wc * 32 + fq * 4;
    if (d.emode == E_GU) {
#pragma unroll
        for (int ai = 0; ai < 2; ++ai)
#pragma unroll
            for (int m = 0; m < 4; ++m) {
                const int row = row0 + ai * HALF + m * 16;
                const float rs = rsqrtf(d.ss[row] * (1.0f / D_) + EPS_);
                bf16_t* op = d.o16 + (size_t)row * F_ + pn * 128 + cw;
#pragma unroll
                for (int n = 0; n < 2; ++n) {
                    const f32x4 g = acc[ai][0][m][n] * rs, u = acc[ai][1][m][n] * rs;
                    float o[4];
#pragma unroll
                    for (int j = 0; j < 4; ++j) o[j] = g[j] * fsigmoid(g[j]) * u[j];
                    u32x2 w; w.x = pk2(o[0], o[1]); w.y = pk2(o[2], o[3]);
                    *(u32x2*)(op + n * 16) = w;
                }
                asm volatile("" ::: "memory");
            }
    } else if (d.emode == E_RESID) {
        const int sub = d.sub;
#pragma unroll
        for (int ai = 0; ai < 2; ++ai)
#pragma unroll
            for (int m = 0; m < 4; ++m) {
                const int row = row0 + ai * HALF + m * 16;
                const size_t off = (size_t)row * D_ + pn * 256 + cw;
                float rs = 1.0f;
                if (sub == 2) rs = rsqrtf(d.ss[row] * (1.0f / D_) + EPS_);
                float q = 0.f;
#pragma unroll
                for (int bj = 0; bj < 2; ++bj)
#pragma unroll
                    for (int n = 0; n < 2; ++n) {
                        const size_t o2 = off + bj * HALF + n * 16;
                        const f32x4 hv = *(const f32x4*)(d.hsrc + o2);
                        f32x4 v = acc[ai][bj][m][n];
                        if (sub == 0) v = v * d.alpha;
                        else if (sub == 1) { const int col = pn * 256 + cw + bj * HALF + n * 16; v = (v + *(const f32x4*)(d.v0 + col)) * *(const f32x4*)(d.v1 + col); }
                        else { const u32x2 pw = *(const u32x2*)(d.pp + o2);
                            v[0] = fsigmoid(v[0] * rs) * bf_lo(pw.x); v[1] = fsigmoid(v[1] * rs) * bf_hi(pw.x);
                            v[2] = fsigmoid(v[2] * rs) * bf_lo(pw.y); v[3] = fsigmoid(v[3] * rs) * bf_hi(pw.y); }
                        const f32x4 hn = hv + v;
                        *(f32x4*)(d.o32 + o2) = hn;
                        u32x2 w; w.x = pk2(hn[0], hn[1]); w.y = pk2(hn[2], hn[3]);
                        *(u32x2*)(d.o16 + o2) = w;
                        q += (hn[0] * hn[0] + hn[1] * hn[1]) + (hn[2] * hn[2] + hn[3] * hn[3]);
                    }
                q += __shfl_xor(q, 16); q += __shfl_xor(q, 32);
                if (fq == 0) atomicAdd(d.ssn + row, q);
                asm volatile("" ::: "memory");
            }
    } else if (d.emode == E_WIN) {
        const bool isg = pn < 5;
        const int pc = (isg ? pn : pn - 5) * 256 + cw;
#pragma unroll
        for (int ai = 0; ai < 2; ++ai)
#pragma unroll
            for (int m = 0; m < 4; ++m) {
                const int row = row0 + ai * HALF + m * 16;
                const float rs = rsqrtf(d.ss[row] * (1.0f / D_) + EPS_);
                const size_t off = (size_t)row * R_ + pc;
#pragma unroll
                for (int bj = 0; bj < 2; ++bj)
#pragma unroll
                    for (int n = 0; n < 2; ++n) {
                        const size_t o2 = off + bj * HALF + n * 16;
                        const f32x4 v = acc[ai][bj][m][n] * rs;
                        if (isg) { u32x2 w; w.x = pk2(gelu_tanh(v[0]), gelu_tanh(v[1])); w.y = pk2(gelu_tanh(v[2]), gelu_tanh(v[3])); *(u32x2*)(d.o16 + o2) = w; }
                        else *(f32x4*)(d.o32 + o2) = v;
                    }
                asm volatile("" ::: "memory");
            }
    } else if (d.emode == E_GATES) {
#pragma unroll
        for (int n = 0; n < 2; ++n) {
            const int c0 = pn * 128 + cw + n * 16;
            const f32x4 ba = *(const f32x4*)(d.v0 + c0), bx = *(const f32x4*)(d.v1 + c0), ap = *(const f32x4*)(d.v2 + c0);
            f32x4 sp8;
#pragma unroll
            for (int j = 0; j < 4; ++j) sp8[j] = 8.0f * log1pf(__expf(-ap[j]));
#pragma unroll
            for (int ai = 0; ai < 2; ++ai)
#pragma unroll
                for (int m = 0; m < 4; ++m) {
                    const int row = row0 + ai * HALF + m * 16;
                    const size_t idx = (size_t)row * R_ + c0;
                    const f32x4 xc = *(const f32x4*)(d.xcb + idx);
                    const f32x4 ar = acc[ai][0][m][n] + ba, ax = acc[ai][1][m][n] + bx;
                    f32x4 av, bv;
#pragma unroll
                    for (int j = 0; j < 4; ++j) {
                        const float r = fsigmoid(ar[j]), ig = fsigmoid(ax[j]);
                        const float la = -sp8[j] * r;
                        av[j] = __expf(la);
                        bv[j] = sqrtf(-expm1f(2.0f * la)) * ig * xc[j];
                    }
                    *(f32x4*)(d.o32 + idx) = av;
                    *(f32x4*)(d.xcb + idx) = bv;
                    asm volatile("" ::: "memory");
                }
        }
    } else {
#pragma unroll
        for (int ai = 0; ai < 2; ++ai)
#pragma unroll
            for (int m = 0; m < 4; ++m) {
                const int row = row0 + ai * HALF + m * 16;
                const size_t off = (size_t)row * D_ + pn * 256 + cw;
#pragma unroll
                for (int bj = 0; bj < 2; ++bj)
#pragma unroll
                    for (int n = 0; n < 2; ++n) {
                        const f32x4 v = acc[ai][bj][m][n];
                        u32x2 w; w.x = pk2(v[0], v[1]); w.y = pk2(v[2], v[3]);
                        *(u32x2*)(d.o16 + off + bj * HALF + n * 16) = w;
                    }
                asm volatile("" ::: "memory");
            }
    }
}

__device__ __forceinline__ void gemm_phase(LAS unsigned char* lds, int daddr, int G, int cidx) {
    daddr = opaque_s(daddr); DescP d = opaque_desc(daddr);
    const int tid = opaque_tid(), wid = __builtin_amdgcn_readfirstlane(tid >> 6), lane = tid & 63, wr = wid >> 2, wc = wid & 3, fr = lane & 15, fq = lane >> 4;
    G = opaque_s(G); cidx = opaque_s(cidx);
    unsigned voffA[2], voffB[2];
#pragma unroll
    for (int i = 0; i < 2; ++i) { int R, C; stage_rc(tid * 16 + i * 8192, R, C);
        voffA[i] = (unsigned)(R * rfl(d->lda) + C) * 2u; voffB[i] = (unsigned)(R * rfl(d->ldb) + C) * 2u; }
    const size_t kstep = (size_t)(BK * 2);
    const size_t hstepA = (size_t)HALF * rfl(d->lda) * 2, hstepB = (size_t)HALF * rfl(d->ldb) * 2;
    const unsigned ldsw = (unsigned)wid * 1024u;
    const int aoff = lds_byte(wr * 64 + fr, fq * 8), boff = lds_byte(wc * 32 + fr, fq * 8);
#define PG8_SA(b, h) (((b) * 2 + (h)) * HTB)
#define PG8_SB(b, h) ((4 + (b) * 2 + (h)) * HTB)
#define PG8_STAGE(bufoff, gbase, voff) do { _Pragma("unroll") for (int _i = 0; _i < 2; ++_i) \
        __builtin_amdgcn_global_load_lds((const unsigned*)((const char*)(gbase) + (voff)[_i]), (LAS unsigned*)(lds + (bufoff) + ldsw + _i * 8192), 16, 0, 0); } while (0)
#define PG8_LDA(dst, b, h) do { _Pragma("unroll") for (int m = 0; m < 4; ++m) _Pragma("unroll") for (int k = 0; k < 2; ++k) dst[m][k] = *(const LAS bf16x8*)(lds + PG8_SA(b, h) + aoff + m * 2048 + k * 1024); } while (0)
#define PG8_LDB(dst, b, h) do { _Pragma("unroll") for (int n = 0; n < 2; ++n) _Pragma("unroll") for (int k = 0; k < 2; ++k) dst[n][k] = *(const LAS bf16x8*)(lds + PG8_SB(b, h) + boff + n * 2048 + k * 1024); } while (0)
#define PG8_MMA(ai, bj, At, Bt) do { __builtin_amdgcn_s_setprio(1); _Pragma("unroll") for (int m = 0; m < 4; ++m) _Pragma("unroll") for (int n = 0; n < 2; ++n) _Pragma("unroll") for (int k = 0; k < 2; ++k) \
        acc[ai][bj][m][n] = __builtin_amdgcn_mfma_f32_16x16x32_bf16(Bt[n][k], At[m][k], acc[ai][bj][m][n], 0, 0, 0); __builtin_amdgcn_s_setprio(0); } while (0)
#define PG8_WAIT_V(n) asm volatile("s_waitcnt vmcnt(" #n ")" ::: "memory")
#define PG8_WAIT_L(n) asm volatile("s_waitcnt lgkmcnt(" #n ")" ::: "memory")
#define PG8_BAR __builtin_amdgcn_s_barrier()
#define PG8_SCHED __builtin_amdgcn_sched_barrier(0)
    Unit cur, nxt; int ui = 0;
    if (!unit_next(daddr, 0, G, cidx, cur)) return;
    f32x4 acc[2][2][4][2];
#pragma unroll
    for (int a = 0; a < 2; ++a)
#pragma unroll
        for (int b = 0; b < 2; ++b)
#pragma unroll
            for (int m = 0; m < 4; ++m)
#pragma unroll
                for (int n = 0; n < 2; ++n) acc[a][b][m][n] = (f32x4){0.f, 0.f, 0.f, 0.f};
    bf16x8 At[4][2], B0[2][2], B1[2][2];
    const char* cA = cur.cA; const char* cB = cur.cB;
    PG8_STAGE(PG8_SB(0, 0), cB, voffB); PG8_STAGE(PG8_SA(0, 0), cA, voffA); PG8_STAGE(PG8_SB(0, 1), cB + hstepB, voffB); PG8_STAGE(PG8_SA(0, 1), cA + hstepA, voffA);
    if (wr == 1) PG8_BAR;
    PG8_WAIT_V(4); PG8_BAR;
    PG8_STAGE(PG8_SB(1, 0), cB + kstep, voffB); PG8_STAGE(PG8_SA(1, 0), cA + kstep, voffA); PG8_STAGE(PG8_SB(1, 1), cB + hstepB + kstep, voffB);
    PG8_WAIT_V(6); PG8_BAR;
    for (;;) {
        const bool has_next = unit_next(daddr, ui + 1, G, cidx, nxt);
        const char* nA = has_next ? nxt.cA : cA; const char* nB = has_next ? nxt.cB : cB;
        const int nt = cur.nt;
        for (int t = 0; t < nt; t += 2) {
            const bool last = (t == nt - 2);
            const char* a1 = cA + (size_t)(t + 1) * kstep;
            const char* a2 = last ? nA : cA + (size_t)(t + 2) * kstep; const char* b2 = last ? nB : cB + (size_t)(t + 2) * kstep;
            const char* a3 = a2 + kstep; const char* b3 = b2 + kstep;
            PG8_LDB(B0, 0, 0); PG8_SCHED; PG8_LDA(At, 0, 0); PG8_STAGE(PG8_SA(1, 1), a1 + hstepA, voffA);
            PG8_WAIT_L(8); PG8_BAR; PG8_WAIT_L(0); PG8_MMA(0, 0, At, B0); PG8_BAR; PG8_SCHED;
            PG8_LDB(B1, 0, 1); PG8_STAGE(PG8_SB(0, 0), b2, voffB);
            PG8_BAR; PG8_WAIT_L(0); PG8_MMA(0, 1, At, B1); PG8_BAR;
            PG8_LDA(At, 0, 1); PG8_STAGE(PG8_SA(0, 0), a2, voffA);
            PG8_BAR; PG8_WAIT_L(0); PG8_MMA(1, 0, At, B0); PG8_BAR; PG8_SCHED;
            PG8_STAGE(PG8_SB(0, 1), b2 + hstepB, voffB);
            PG8_WAIT_V(6); PG8_BAR; PG8_MMA(1, 1, At, B1); PG8_BAR;
            PG8_LDB(B0, 1, 0); PG8_SCHED; PG8_LDA(At, 1, 0); PG8_STAGE(PG8_SA(0, 1), a2 + hstepA, voffA);
            PG8_WAIT_L(8); PG8_BAR; PG8_WAIT_L(0); PG8_MMA(0, 0, At, B0); PG8_BAR; PG8_SCHED;
            PG8_LDB(B1, 1, 1); PG8_STAGE(PG8_SB(1, 0), b3, voffB);
            PG8_BAR; PG8_WAIT_L(0); PG8_MMA(0, 1, At, B1); PG8_BAR;
            PG8_LDA(At, 1, 1); PG8_STAGE(PG8_SA(1, 0), a3, voffA);
            PG8_BAR; PG8_WAIT_L(0); PG8_MMA(1, 0, At, B0); PG8_BAR; PG8_SCHED;
            PG8_STAGE(PG8_SB(1, 1), b3 + hstepB, voffB);
            PG8_WAIT_V(6); PG8_BAR; PG8_MMA(1, 1, At, B1); PG8_BAR;
        }
        epilogue(daddr, acc, cur.pm, cur.pn, wr, wc, fr, fq);
        if (!has_next) break;
#pragma unroll
        for (int a = 0; a < 2; ++a)
#pragma unroll
            for (int b = 0; b < 2; ++b)
#pragma unroll
                for (int m = 0; m < 4; ++m)
#pragma unroll
                    for (int n = 0; n < 2; ++n) acc[a][b][m][n] = (f32x4){0.f, 0.f, 0.f, 0.f};
        cur = nxt; cA = nA; cB = nB; ++ui;
    }
    PG8_WAIT_V(0);
    if (wr == 0) PG8_BAR;
    PG8_BAR;
#undef PG8_SA
#undef PG8_SB
#undef PG8_STAGE
#undef PG8_LDA
#undef PG8_LDB
#undef PG8_MMA
#undef PG8_WAIT_V
#undef PG8_WAIT_L
#undef PG8_BAR
#undef PG8_SCHED
}

typedef const LAS Params* PLp;
__device__ __forceinline__ PLp opaque_pl() { unsigned a = LDS_PL; asm volatile("" : "+v"(a)); return (PLp)a; }
__device__ __forceinline__ void transpose_item(const float* W, int K, int N, bf16_t* WT, int gumode, int guoff, const float* scale, LAS float* scr, int item, int lane) {
    const int nblk = N / 32, kb = item / nblk, nb = item % nblk, k0 = 64 * kb, n0 = 32 * nb;
    const int row0 = gumode ? ((n0 >> 7) * 256 + guoff + (n0 & 127)) : n0;
#pragma unroll 8
    for (int i = 0; i < 32; ++i) { const int kk = 2 * i + (lane >> 5); float v = W[(size_t)(k0 + kk) * N + n0 + (lane & 31)]; if (scale) v *= scale[k0 + kk]; scr[kk * 33 + (lane & 31)] = v; }
    LDS_WAIT(); asm volatile("" ::: "memory");
    const int c = lane & 7;
#pragma unroll
    for (int j = 0; j < 4; ++j) { const int n = (lane >> 3) + 8 * j; const LAS float* s = scr + (8 * c) * 33 + n;
        u32x4 o; o.x = pk2(s[0 * 33], s[1 * 33]); o.y = pk2(s[2 * 33], s[3 * 33]); o.z = pk2(s[4 * 33], s[5 * 33]); o.w = pk2(s[6 * 33], s[7 * 33]);
        *(u32x4*)(WT + (size_t)(row0 + n) * K + k0 + 8 * c) = o; }
    LDS_WAIT(); asm volatile("" ::: "memory");
}

__device__ __forceinline__ void prep_layer(PLp P, int layer, size_t wloff, LAS unsigned char* lds, int G) {
    P = opaque_pl(); unsigned char* wl = P->ws + wloff;
    const int tid = opaque_tid(), lane = tid & 63, wave = __builtin_amdgcn_readfirstlane(tid >> 6); G = opaque_s(G); const int bid = opaque_bid();
    LAS float* scr = (LAS float*)(lds + wave * 8448);
    const int gw = bid * NWAVES + wave, NGW = G * NWAVES;
    const int jl = layer >> 1; const bool lru = (layer & 1) == 0;
    constexpr int I_GU = (D_ / 64) * (F_ / 32), I_DN = (F_ / 64) * (D_ / 32), I_PGt = (D_ / 64) * (D_ / 32), I_PPt = (PLE_ / 64) * (D_ / 32);
    constexpr int I_WIN = (D_ / 64) * (2 * R_ / 32), I_WOUT = (R_ / 64) * (D_ / 32), I_POOL = 4 * (256 / 64) * (256 / 32);
    const int nmix = lru ? (I_WIN + I_WOUT) : I_POOL;
    const int NITEMS = 6 * I_GU + I_PGt + I_PPt + nmix;
    static_assert(I_GU == I_DN, "items");
    const size_t WFF = (size_t)D_ * F_;
    for (int it = gw; it < NITEMS; it += NGW) {
        int r = it;
        const float* W; int K, N; bf16_t* WT; int gumode = 0, guoff = 0; const float* scale = nullptr;
        if (r < 3 * I_GU) {
            const int which = r / I_GU; r -= which * I_GU;
            if (which < 2) { W = P->in[which ? I_F1U : I_F1G] + layer * WFF; K = D_; N = F_; WT = (bf16_t*)(wl + WL_GU1); gumode = 1; guoff = which * 128; scale = P->in[I_F1N] + layer * D_; }
            else { W = P->in[I_F1D] + layer * WFF; K = F_; N = D_; WT = (bf16_t*)(wl + WL_D1); }
        } else if (r < 6 * I_GU) {
            r -= 3 * I_GU; const int which = r / I_GU; r -= which * I_GU;
            if (which < 2) { W = P->in[which ? I_F2U : I_F2G] + layer * WFF; K = D_; N = F_; WT = (bf16_t*)(wl + WL_GU2); gumode = 1; guoff = which * 128; scale = P->in[I_F2N] + layer * D_; }
            else { W = P->in[I_F2D] + layer * WFF; K = F_; N = D_; WT = (bf16_t*)(wl + WL_D2); }
        } else {
            r -= 6 * I_GU;
            if (r < I_PGt) { W = P->in[I_PLG] + (size_t)layer * D_ * D_; K = D_; N = D_; WT = (bf16_t*)(wl + WL_PG); scale = P->in[I_PLN] + layer * D_; }
            else if (r < I_PGt + I_PPt) { r -= I_PGt; W = P->in[I_PLP] + (size_t)layer * PLE_ * D_; K = PLE_; N = D_; WT = (bf16_t*)(wl + WL_PP); }
            else {
                r -= I_PGt + I_PPt;
                if (lru) {
                    if (r < I_WIN) { W = P->in[I_LWIN] + (size_t)jl * D_ * 2 * R_; K = D_; N = 2 * R_; WT = (bf16_t*)(wl + WL_WIN); scale = P->in[I_MIXN] + layer * D_; }
                    else { r -= I_WIN; W = P->in[I_LWOUT] + (size_t)jl * R_ * D_; K = R_; N = D_; WT = (bf16_t*)(wl + WL_WOUT); }
                } else {
                    const int g = r / 32; r = r % 32;
                    W = P->in[I_PW] + ((size_t)jl * 4 + g) * 256 * 256; K = 256; N = 256; WT = (bf16_t*)(wl + WL_MIX) + (size_t)g * 256 * 256; scale = P->in[I_MIXN] + layer * D_ + g * 256;
                }
            }
        }
        K = opaque_s(rfl(K)); N = opaque_s(rfl(N));
        transpose_item(W, K, N, WT, gumode, guoff, scale, scr, r, lane);
    }
    const int gt = bid * NTHR + tid, NGT = G * NTHR;
    {
        const float* src = P->in[I_P] + (size_t)layer * M_ * PLE_; bf16_t* dst = (bf16_t*)(wl + WL_PB);
        for (int i = gt; i < M_ * PLE_ / 8; i += NGT) {
            const f32x4 a = *(const f32x4*)(src + (size_t)i * 8), b = *(const f32x4*)(src + (size_t)i * 8 + 4);
            u32x4 o; o.x = pk2(a[0], a[1]); o.y = pk2(a[2], a[3]); o.z = pk2(b[0], b[1]); o.w = pk2(b[2], b[3]);
            *(u32x4*)(dst + (size_t)i * 8) = o;
        }
    }
    if (lru) {
        const float* wa = P->in[I_LWA] + (size_t)jl * 16 * 80 * 80; const float* wx = P->in[I_LWX] + (size_t)jl * 16 * 80 * 80;
        bf16_t* dst = (bf16_t*)(wl + WL_WG);
        for (int i = gt; i < 2 * R_ * (R_ / 8); i += NGT) {
            const int row = i / (R_ / 8), k8 = (i % (R_ / 8)) * 8;
            const int t = row >> 8, w = row & 255; const bool isI = w >= 128; const int c = t * 128 + (w & 127), h = c / 80, j = c % 80;
            const float* src = (isI ? wx : wa) + (size_t)h * 80 * 80 + j;
            float v[8];
#pragma unroll
            for (int e = 0; e < 8; ++e) { const int k = k8 + e, ki = k - h * 80; v[e] = (ki >= 0 && ki < 80) ? src[ki * 80] : 0.f; }
            u32x4 o; o.x = pk2(v[0], v[1]); o.y = pk2(v[2], v[3]); o.z = pk2(v[4], v[5]); o.w = pk2(v[6], v[7]);
            *(u32x4*)(dst + (size_t)row * R_ + k8) = o;
        }
    }
}

__device__ __forceinline__ void init_phase(PLp P, int G) {
    P = opaque_pl();
    const int tid = opaque_tid(), lane = tid & 63, wave = tid >> 6; G = opaque_s(G); const int bid = opaque_bid();
    const int gw = bid * NWAVES + wave, NGW = G * NWAVES;
    float* ss = (float*)(P->ws + OFF_SS);
    bf16_t* hb = (bf16_t*)(P->ws + OFF_HB0);
    for (int row = gw; row < M_; row += NGW) {
        const f32x4* xr = (const f32x4*)(P->in[I_X] + (size_t)row * D_) + lane;
        u32x2* o8 = (u32x2*)(hb + (size_t)row * D_) + lane;
        float s = 0.f;
#pragma unroll
        for (int j = 0; j < 4; ++j) { const f32x4 v = xr[64 * j]; s += (v[0] * v[0] + v[1] * v[1]) + (v[2] * v[2] + v[3] * v[3]); u32x2 w; w.x = pk2(v[0], v[1]); w.y = pk2(v[2], v[3]); o8[64 * j] = w; }
        s = wave_sum(s);
        if (lane == 0) ss[row] = s;
    }
    const int gt = bid * NTHR + tid, NGT = G * NTHR;
    for (int i = gt; i < 16 * M_ / 4; i += NGT) *(f32x4*)(ss + SS_STRIDE + (size_t)i * 4) = (f32x4){0.f, 0.f, 0.f, 0.f};
}

__device__ __forceinline__ void final_phase(PLp P, int G) {
    P = opaque_pl();
    const int tid = opaque_tid(), lane = tid & 63, wave = tid >> 6; G = opaque_s(G);
    const int gw = opaque_bid() * NWAVES + wave, NGW = G * NWAVES;
    const float* ss = (const float*)(P->ws + OFF_SS) + 16 * SS_STRIDE;
    const f32x4* fn = (const f32x4*)P->in[I_FN] + lane;
    for (int row = gw; row < M_; row += NGW) {
        f32x4* xr = (f32x4*)(P->out + (size_t)row * D_) + lane;
        const float rs = rsqrtf(ss[row] * (1.0f / D_) + EPS_);
#pragma unroll
        for (int j = 0; j < 4; ++j) xr[64 * j] = xr[64 * j] * rs * fn[64 * j];
    }
}

__device__ __forceinline__ void conv_phase(PLp P, int jl, int G) {
    P = opaque_pl();
    G = opaque_s(G); const int gt = opaque_bid() * NTHR + opaque_tid(), NGT = G * NTHR;
    const float* XB = (const float*)(P->ws + OFF_R1); float* XC = (float*)(P->ws + OFF_R2); bf16_t* XCb = (bf16_t*)(P->ws + OFF_R4);
    const float* cw = P->in[I_LCW] + (size_t)jl * 4 * R_; const float* cb = P->in[I_LCB] + (size_t)jl * R_;
    for (int i = gt; i < (M_ / 16) * (R_ / 4); i += NGT) {
        const int tb = i / (R_ / 4), c4 = (i % (R_ / 4)) * 4, row0 = tb * 16;
        const f32x4 w0 = *(const f32x4*)(cw + c4), w1 = *(const f32x4*)(cw + R_ + c4), w2 = *(const f32x4*)(cw + 2 * R_ + c4), w3 = *(const f32x4*)(cw + 3 * R_ + c4), b = *(const f32x4*)(cb + c4);
        f32x4 xm3 = (f32x4){0.f, 0.f, 0.f, 0.f}, xm2 = xm3, xm1 = xm3;
        if ((row0 & (S_ - 1)) != 0) { xm3 = *(const f32x4*)(XB + (size_t)(row0 - 3) * R_ + c4); xm2 = *(const f32x4*)(XB + (size_t)(row0 - 2) * R_ + c4); xm1 = *(const f32x4*)(XB + (size_t)(row0 - 1) * R_ + c4); }
#pragma unroll 4
        for (int t = 0; t < 16; ++t) {
            const size_t idx = (size_t)(row0 + t) * R_ + c4;
            const f32x4 x = *(const f32x4*)(XB + idx);
            const f32x4 xc = b + w0 * xm3 + w1 * xm2 + w2 * xm1 + w3 * x;
            *(f32x4*)(XC + idx) = xc;
            u32x2 w; w.x = pk2(xc[0], xc[1]); w.y = pk2(xc[2], xc[3]); *(u32x2*)(XCb + idx) = w;
            xm3 = xm2; xm2 = xm1; xm1 = x;
        }
    }
}

__device__ __forceinline__ void scan1_phase(PLp P, int G) {
    P = opaque_pl();
    G = opaque_s(G); const int gt = opaque_bid() * NTHR + opaque_tid(), NGT = G * NTHR;
    const float* Aa = (const float*)(P->ws + OFF_R1); const float* Bb = (const float*)(P->ws + OFF_R2);
    float* aggP = (float*)(P->ws + OFF_AGG); float* aggH = aggP + AGG_ELEMS;
    for (int i = gt; i < 2 * 128 * (R_ / 2); i += NGT) {
        const int bc = i / (R_ / 2), c2 = (i % (R_ / 2)) * 2;
        const size_t base = (size_t)bc * 64 * R_ + c2;
        f32x2 h = (f32x2){0.f, 0.f}, p = (f32x2){1.f, 1.f};
#pragma unroll 8
        for (int t = 0; t < 64; ++t) { const f32x2 a = *(const f32x2*)(Aa + base + (size_t)t * R_), b = *(const f32x2*)(Bb + base + (size_t)t * R_); h = a * h + b; p = p * a; }
        *(f32x2*)(aggP + (size_t)bc * R_ + c2) = p; *(f32x2*)(aggH + (size_t)bc * R_ + c2) = h;
    }
}
__device__ __forceinline__ void scan2_phase(PLp P, int G) {
    P = opaque_pl();
    G = opaque_s(G); const int gt = opaque_bid() * NTHR + opaque_tid(), NGT = G * NTHR;
    const float* Aa = (const float*)(P->ws + OFF_R1); const float* Bb = (const float*)(P->ws + OFF_R2);
    const float* aggP = (const float*)(P->ws + OFF_AGG); const float* aggH = aggP + AGG_ELEMS;
    const bf16_t* Gg = (const bf16_t*)(P->ws + OFF_R5); bf16_t* Y = (bf16_t*)(P->ws + OFF_R4);
    for (int i = gt; i < 2 * 128 * (R_ / 2); i += NGT) {
        const int bc = i / (R_ / 2), c2 = (i % (R_ / 2)) * 2, chunk = bc & 127, b0 = bc - chunk;
        f32x2 h = (f32x2){0.f, 0.f};
#pragma unroll 8
        for (int j = 0; j < chunk; ++j) { const f32x2 a = *(const f32x2*)(aggP + (size_t)(b0 + j) * R_ + c2), b = *(const f32x2*)(aggH + (size_t)(b0 + j) * R_ + c2); h = a * h + b; }
        const size_t base = (size_t)bc * 64 * R_ + c2;
#pragma unroll 8
        for (int t = 0; t < 64; ++t) {
            const size_t idx = base + (size_t)t * R_;
            const f32x2 a = *(const f32x2*)(Aa + idx), b = *(const f32x2*)(Bb + idx); h = a * h + b;
            const unsigned g = *(const unsigned*)(Gg + idx);
            *(unsigned*)(Y + idx) = pk2(h[0] * bf_lo(g), h[1] * bf_hi(g));
        }
    }
}

__device__ __forceinline__ void pool_prep_phase(PLp P, int layer, LAS unsigned char* lds, int G) {
    P = opaque_pl();
    const int tid = opaque_tid(); G = opaque_s(G);
    const float* h = P->out; const float* ss = (const float*)(P->ws + OFF_SS) + (size_t)(4 * layer + 1) * SS_STRIDE;
    bf16_t* U = (bf16_t*)(P->ws + OFF_R1);
    LAS float* T = (LAS float*)lds;
    for (int it = opaque_bid(); it < 1024; it += G) {
        const int tt = it >> 2, g = it & 3, W = 2 << g, base = tt * 64, tl0 = base & (S_ - 1);
        {
            const int c4 = tid & 63, rq = tid >> 6;
            for (int s = 16 - W + rq; s < 79; s += 8) {
                const int rel = s - 15;
                f32x4 v = (f32x4){0.f, 0.f, 0.f, 0.f};
                if (tl0 + rel >= 0) { const int row = base + rel; const float rs = rsqrtf(ss[row] * (1.0f / D_) + EPS_); v = *(const f32x4*)(h + (size_t)row * D_ + g * 256 + c4 * 4) * rs; }
                *(LAS f32x4*)(T + s * 256 + c4 * 4) = v;
            }
        }
        __syncthreads();
        {
            const int c4 = tid & 63, tq = tid >> 6;
#pragma unroll 2
            for (int j = 0; j < 8; ++j) {
                const int tl = tq + 8 * j, tloc = tl0 + tl;
                const int cnt = (tloc + 1 < W) ? (tloc + 1) : W;
                const f32x4 cur = *(const LAS f32x4*)(T + (tl + 15) * 256 + c4 * 4);
                f32x4 sum = cur;
                for (int s = 1; s < W; ++s) sum += *(const LAS f32x4*)(T + (tl + 15 - s) * 256 + c4 * 4);
                const f32x4 u = sum * (1.0f / (float)cnt) - cur;
                u32x2 w; w.x = pk2(u[0], u[1]); w.y = pk2(u[2], u[3]);
                *(u32x2*)(U + (size_t)(base + tl) * D_ + g * 256 + c4 * 4) = w;
            }
        }
        __syncthreads();
    }
}

__device__ __forceinline__ void build_table(PLp PL, LAS GemmDesc* tab) {
    unsigned char* ws = PL->ws; float* out = PL->out;
    float* SS = (float*)(ws + OFF_SS);
    bf16_t* HB0 = (bf16_t*)(ws + OFF_HB0);
    bf16_t* HB1 = (bf16_t*)(ws + OFF_R2);
    for (int step = 0; step < 40; ++step) {
        int layer, s;
        if (step < 12) { layer = 0; s = step; } else if (step < 20) { layer = 1; s = step - 12; } else if (step < 32) { layer = 2; s = step - 20; } else { layer = 3; s = step - 32; }
        const int op = (layer & 1) ? (s < 2 ? s : (s < 4 ? s + 10 : s + 4)) : s;
        const int jl = layer >> 1;
        unsigned char* wl = ws + ((layer & 1) ? OFF_WL1 : OFF_WL0);
        LAS GemmDesc& d = tab[step];
        d.op = op; d.layer = layer;
        d.A = nullptr; d.Bt = nullptr; d.lda = 0; d.ldb = 0; d.nN = 0; d.nt = 0; d.emode = 0;
        d.nM = M_ / 256; d.kmode = 0; d.sub = 0; d.alpha = 1.0f;
        d.ss = nullptr; d.o16 = nullptr; d.o32 = nullptr; d.hsrc = nullptr; d.ssn = nullptr; d.v0 = nullptr; d.v1 = nullptr; d.v2 = nullptr; d.pp = nullptr; d.xcb = nullptr;
        if (op == 0 || op == 8) {
            const bool first = (op == 0);
            d.A = first ? (layer == 0 ? HB0 : HB1) : HB0; d.lda = D_;
            d.Bt = (const bf16_t*)(wl + (first ? WL_GU1 : WL_GU2)); d.ldb = D_; d.nN = 2 * F_ / 256; d.nt = D_ / 64;
            d.emode = E_GU; d.ss = SS + (size_t)(4 * layer + (first ? 0 : 2)) * SS_STRIDE; d.o16 = (bf16_t*)(ws + OFF_R1);
        } else if (op == 1 || op == 9) {
            const bool first = (op == 1);
            d.A = (const bf16_t*)(ws + OFF_R1); d.lda = F_;
            d.Bt = (const bf16_t*)(wl + (first ? WL_D1 : WL_D2)); d.ldb = F_; d.nN = D_ / 256; d.nt = F_ / 64;
            d.emode = E_RESID; d.sub = 0; d.alpha = 0.5f;
            d.hsrc = (first && layer == 0) ? PL->in[I_X] : out; d.o32 = out; d.o16 = HB0;
            d.ssn = SS + (size_t)(4 * layer + (first ? 1 : 3)) * SS_STRIDE;
        } else if (op == 2) {
            d.A = HB0; d.lda = D_; d.Bt = (const bf16_t*)(wl + WL_WIN); d.ldb = D_; d.nN = 2 * R_ / 256; d.nt = D_ / 64;
            d.emode = E_WIN; d.ss = SS + (size_t)(4 * layer + 1) * SS_STRIDE; d.o16 = (bf16_t*)(ws + OFF_R5); d.o32 = (float*)(ws + OFF_R1);
        } else if (op == 4) {
            d.A = (const bf16_t*)(ws + OFF_R4); d.lda = R_; d.Bt = (const bf16_t*)(wl + WL_WG); d.ldb = R_; d.nN = 2 * R_ / 256; d.nt = 0; d.kmode = 2;
            d.emode = E_GATES; d.v0 = PL->in[I_LBA] + (size_t)jl * R_; d.v1 = PL->in[I_LBX] + (size_t)jl * R_; d.v2 = PL->in[I_LAP] + (size_t)jl * R_;
            d.o32 = (float*)(ws + OFF_R1); d.xcb = (float*)(ws + OFF_R2);
        } else if (op == 7) {
            d.A = (const bf16_t*)(ws + OFF_R4); d.lda = R_; d.Bt = (const bf16_t*)(wl + WL_WOUT); d.ldb = R_; d.nN = D_ / 256; d.nt = R_ / 64;
            d.emode = E_RESID; d.sub = 0; d.alpha = 1.0f; d.hsrc = out; d.o32 = out; d.o16 = HB0; d.ssn = SS + (size_t)(4 * layer + 2) * SS_STRIDE;
        } else if (op == 13) {
            d.A = (const bf16_t*)(ws + OFF_R1); d.lda = D_; d.Bt = (const bf16_t*)(wl + WL_MIX); d.ldb = 256; d.nN = D_ / 256; d.nt = 4; d.kmode = 1;
            d.emode = E_RESID; d.sub = 1; d.v0 = PL->in[I_PB] + (size_t)jl * D_; d.v1 = PL->in[I_PS] + (size_t)jl * D_;
            d.hsrc = out; d.o32 = out; d.o16 = HB0; d.ssn = SS + (size_t)(4 * layer + 2) * SS_STRIDE;
        } else if (op == 10) {
            d.A = (const bf16_t*)(wl + WL_PB); d.lda = PLE_; d.Bt = (const bf16_t*)(wl + WL_PP); d.ldb = PLE_; d.nN = D_ / 256; d.nt = PLE_ / 64;
            d.emode = E_PROJ; d.o16 = (bf16_t*)(ws + OFF_R1);
        } else if (op == 11) {
            d.A = HB0; d.lda = D_; d.Bt = (const bf16_t*)(wl + WL_PG); d.ldb = D_; d.nN = D_ / 256; d.nt = D_ / 64;
            d.emode = E_RESID; d.sub = 2; d.ss = SS + (size_t)(4 * layer + 3) * SS_STRIDE; d.pp = (const bf16_t*)(ws + OFF_R1);
            d.hsrc = out; d.o32 = out; d.o16 = HB1; d.ssn = SS + (size_t)(4 * layer + 4) * SS_STRIDE;
        }
    }
}

__global__ void __launch_bounds__(NTHR, 2) fwd_megakernel(Params P) {
    extern __shared__ __attribute__((aligned(16))) unsigned char lds_raw[];
    LAS unsigned char* lds = (LAS unsigned char*)lds_raw;
    const int tid = threadIdx.x, G = gridDim.x;
    volatile LAS unsigned* st = (volatile LAS unsigned*)(lds + LDS_STAGE);
    LAS Params* PLw = (LAS Params*)(lds + LDS_PL);
    static_assert(sizeof(Params) <= 256 && sizeof(GemmDesc) == DESC_BYTES, "lds ctl");
    if (tid == 0) {
        st[0] = 0u; st[1] = 0u; st[2] = 0u; st[3] = 0u;
#pragma unroll
        for (int i = 0; i < 27; ++i) PLw->in[i] = P.in[i];
        PLw->out = P.out; PLw->ws = P.ws; PLw->lo = P.lo; PLw->hi = P.hi;
        build_table((PLp)PLw, (LAS GemmDesc*)(lds + LDS_DL));
    }
    __syncthreads();
    PLp PL = (PLp)PLw;
    const int lo = P.lo, hi = P.hi;
#if ONE_LAUNCH
    xcd_barrier_post((unsigned*)(P.ws + OFF_CTL), st);
    __syncthreads();
#endif

    for (int step = lo; step < hi; ++step) {
        if (step == -1) {
            init_phase(PL, G);
            prep_layer(PL, 0, OFF_WL0, lds, G);
#if ONE_LAUNCH
            cg::this_grid().sync();
#endif
            continue;
        }
        if (step == 40) { final_phase(PL, G); continue; }
        const int daddr = LDS_DL + step * DESC_BYTES;
        DescP dd = opaque_desc(daddr);
        const int op = rfl(dd->op), layer = rfl(dd->layer);
        if (op == 3) conv_phase(PL, layer >> 1, G);
        else if (op == 5) scan1_phase(PL, G);
        else if (op == 6) scan2_phase(PL, G);
        else if (op == 12) pool_prep_phase(PL, layer, lds, G);
        else {
            gemm_phase(lds, daddr, G, (int)blockIdx.x);
            if (op == 10 && layer < 3) prep_layer(PL, layer + 1, ((layer + 1) & 1) ? OFF_WL1 : OFF_WL0, lds, G);
        }
#if ONE_LAUNCH
        xcd_barrier(st);
#endif
    }
}

extern "C" void kernel_launch(void* const* d_in, const int* in_sizes, int n_in, void* d_out, int out_size, void* d_ws, size_t ws_size, hipStream_t stream) {
    static int grid = 0;
    if (grid == 0) {
        if (n_in != 27 || out_size != M_ * D_ || ws_size < WS_END) { fprintf(stderr, "kernel_launch: bad shapes n_in %d out %d ws %zu (need %zu)\n", n_in, out_size, ws_size, (size_t)WS_END); grid = -1; return; }
        int dev = 0, cus = 0, per_cu = 0;
        hipGetDevice(&dev); hipDeviceGetAttribute(&cus, hipDeviceAttributeMultiprocessorCount, dev);
        if (hipFuncSetAttribute((const void*)fwd_megakernel, hipFuncAttributeMaxDynamicSharedMemorySize, LDS_BYTES) != hipSuccess) { fprintf(stderr, "kernel_launch: hipFuncSetAttribute failed\n"); grid = -1; return; }
        hipOccupancyMaxActiveBlocksPerMultiprocessor(&per_cu, (const void*)fwd_megakernel, NTHR, LDS_BYTES);
        (void)hipGetLastError();
        if (per_cu < 1) fprintf(stderr, "kernel_launch: occupancy query reports %d blocks per CU\n", per_cu);
        grid = cus;
    }
    if (grid < 0) return;
    hipMemsetAsync((char*)d_ws + OFF_CTL, 0, 16384, stream);
    Params p{};
    for (int i = 0; i < 27; ++i) p.in[i] = (const float*)d_in[i];
    p.out = (float*)d_out; p.ws = (unsigned char*)d_ws;
#if ONE_LAUNCH
    p.lo = -1; p.hi = 41;
    void* args[] = {&p};
    hipError_t e = hipLaunchCooperativeKernel((const void*)fwd_megakernel, dim3(grid), dim3(NTHR), args, LDS_BYTES, stream);
    if (e != hipSuccess) fprintf(stderr, "cooperative launch failed: %s (grid %d)\n", hipGetErrorString(e), grid);
#else
    for (int s = -1; s < 41; ++s) { p.lo = s; p.hi = s + 1; hipLaunchKernelGGL(fwd_megakernel, dim3(grid), dim3(NTHR), LDS_BYTES, stream, p); }
#endif
}
```

```cpp
#include <hip/hip_runtime.h>
#include <hip/hip_cooperative_groups.h>
#include <cstdio>
namespace cg = cooperative_groups;

#ifndef ONE_LAUNCH
#define ONE_LAUNCH 1
#endif

#ifndef TMASK
#define TMASK 0
#endif
#define TMULT 4
#ifndef TBLK
#define TBLK 0
#endif
#define LAS __attribute__((address_space(3)))
typedef unsigned short bf16_t;
typedef short bf16x8 __attribute__((ext_vector_type(8)));
typedef float f32x4 __attribute__((ext_vector_type(4)));
typedef float f32x2 __attribute__((ext_vector_type(2)));
typedef unsigned u32x4 __attribute__((ext_vector_type(4)));
typedef unsigned u32x2 __attribute__((ext_vector_type(2)));

constexpr int M_ = 16384, D_ = 1024, F_ = 2816, R_ = 1280, S_ = 8192, PLE_ = 256;
constexpr float EPS_ = 1e-6f;
constexpr int NTHR = 512, NWAVES = 8;

constexpr size_t OFF_CTL = 0;
constexpr size_t OFF_SS  = 16384;
constexpr size_t SS_STRIDE = (size_t)M_;
constexpr size_t OFF_AGG = OFF_SS + 17 * SS_STRIDE * 8;
constexpr float SS_FX = 16777216.0f, SS_IFX = 1.0f / 16777216.0f;
constexpr size_t AGG_ELEMS = (size_t)2 * 128 * R_;
constexpr size_t OFF_WL0 = OFF_AGG + 2 * AGG_ELEMS * 4;
constexpr size_t WL_GU1 = 0;
constexpr size_t WL_D1  = WL_GU1 + (size_t)2 * F_ * D_ * 2;
constexpr size_t WL_GU2 = WL_D1 + (size_t)D_ * F_ * 2;
constexpr size_t WL_D2  = WL_GU2 + (size_t)2 * F_ * D_ * 2;
constexpr size_t WL_MIX = WL_D2 + (size_t)D_ * F_ * 2;
constexpr size_t WL_WIN = WL_MIX;
constexpr size_t WL_WG  = WL_WIN + (size_t)2 * R_ * D_ * 2;
constexpr size_t WL_WOUT = WL_WG + (size_t)2 * R_ * R_ * 2;
constexpr size_t WL_PG  = WL_WOUT + (size_t)D_ * R_ * 2;
constexpr size_t WL_SIZE = WL_PG + (size_t)D_ * D_ * 2;
constexpr size_t OFF_WL1 = OFF_WL0 + WL_SIZE;
constexpr size_t OFF_HB0 = OFF_WL1 + WL_SIZE;
constexpr size_t OFF_R1  = OFF_HB0 + (size_t)M_ * D_ * 2;
constexpr size_t OFF_R2  = OFF_R1 + (size_t)M_ * F_ * 2;
constexpr size_t OFF_R4  = OFF_R2 + (size_t)M_ * R_ * 4;
constexpr size_t OFF_R5  = OFF_R4 + (size_t)M_ * R_ * 2;
constexpr size_t OFF_PBALL = OFF_R5 + (size_t)M_ * R_ * 2;
constexpr size_t OFF_WPPALL = OFF_PBALL + (size_t)M_ * D_ * 2;
constexpr size_t WS_END  = OFF_WPPALL + (size_t)D_ * D_ * 2;
static_assert(OFF_WL0 % 256 == 0 && WL_SIZE % 256 == 0, "align");

constexpr int LDS_STAGE = 131072;
constexpr int LDS_PL = LDS_STAGE + 64, LDS_DL = LDS_PL + 256, DESC_BYTES = 152, LDS_RSC = LDS_DL + 40 * DESC_BYTES, LDS_BYTES = LDS_RSC + 8 * 512 * 4;

struct Params {
    const float* in[27];
    float* out;
    unsigned char* ws;
    int lo, hi;
};
enum { I_X = 0, I_P, I_F1N, I_F1G, I_F1U, I_F1D, I_MIXN, I_LWIN, I_LCW, I_LCB, I_LWA, I_LBA, I_LWX, I_LBX, I_LAP, I_LWOUT,
       I_PW, I_PB, I_PS, I_F2N, I_F2G, I_F2U, I_F2D, I_PLN, I_PLG, I_PLP, I_FN };

__device__ __forceinline__ unsigned pk2(float lo, float hi) { unsigned r; asm volatile("v_cvt_pk_bf16_f32 %0, %1, %2" : "=v"(r) : "v"(lo), "v"(hi)); return r; }
__device__ __forceinline__ float bf_lo(unsigned w) { return __uint_as_float(w << 16); }
__device__ __forceinline__ float bf_hi(unsigned w) { return __uint_as_float(w & 0xffff0000u); }
__device__ __forceinline__ float fsigmoid(float x) { return __builtin_amdgcn_rcpf(1.0f + __expf(-x)); }
__device__ __forceinline__ float wave_sum(float v) {
#pragma unroll
    for (int o = 1; o < 64; o <<= 1) v += __shfl_xor(v, o);
    return v;
}
__device__ __forceinline__ int opaque_tid() { int t = threadIdx.x; asm volatile("" : "+v"(t)); return t; }
__device__ __forceinline__ int opaque_bid() { int b = blockIdx.x; asm volatile("" : "+s"(b)); return b; }
__device__ __forceinline__ int opaque_s(int v) { v = __builtin_amdgcn_readfirstlane(v); asm volatile("" : "+s"(v)); return v; }
__device__ __forceinline__ void st_wt8(void* p, u32x2 v) { *(u32x2*)p = v; }
__device__ __forceinline__ void st_wt16f(float* p, f32x4 v) { *(f32x4*)p = v; }
__device__ __forceinline__ f32x4 zero4() { float z = 0.f; asm volatile("" : "+v"(z)); return (f32x4){z, z, z, z}; }
typedef unsigned long long u64;
__device__ __forceinline__ float ss_get(const float* p, int row) { return (float)(((const u64*)p)[row]) * SS_IFX; }
#define LDS_WAIT() asm volatile("s_waitcnt lgkmcnt(0)" ::: "memory")

#define XB_TMO      128
#define XB_XCNT(j)  (256  + 64 * (j))
#define XB_XSUB(j)  (1280 + 64 * (j))
#define XB_XGEN(j)  (2304 + 64 * (j))
#define XB_TOP      3328
#define XB_TOPGEN   3392
#define XCD_BAR_WORDS 3456
#define XB_SPIN_CAP (1u << 22)
__device__ __forceinline__ unsigned xb_ld(unsigned* p)              { return __hip_atomic_load(p, __ATOMIC_RELAXED, __HIP_MEMORY_SCOPE_AGENT); }
__device__ __forceinline__ unsigned xb_add(unsigned* p, unsigned v) { return __hip_atomic_fetch_add(p, v, __ATOMIC_RELAXED, __HIP_MEMORY_SCOPE_AGENT); }
__device__ __forceinline__ unsigned xb_xcc_id() { return (unsigned)__builtin_amdgcn_s_getreg((3 << 11) | 20) & 0xFu; }
#define XB_SPIN(cond, bar) do { unsigned _sp = 0; while (cond) { __builtin_amdgcn_s_sleep(1); \
    if ((++_sp & 255u) == 0u) { if (xb_ld(&(bar)[XB_TMO])) break; if (_sp > XB_SPIN_CAP) { atomicAdd(&(bar)[XB_TMO], 1u); break; } } } } while (0)
__device__ __forceinline__ void xcd_barrier_post(unsigned* bar, volatile LAS unsigned* st) {
    if (threadIdx.x == 0) { const unsigned x = xb_xcc_id(); st[2] = x; *(volatile LAS unsigned long long*)(st + 4) = (unsigned long long)bar; (void)xb_add(&bar[XB_XCNT(x)], 1u); }
}
__device__ __forceinline__ void xcd_barrier_complete(unsigned* bar, unsigned x, unsigned& nloc, unsigned& nx) {
    const unsigned G = gridDim.x * gridDim.y * gridDim.z;
    unsigned sum, cnt, mine, sp = 0u;
    for (;;) {
        sum = 0u; cnt = 0u;
        for (unsigned j = 0; j < 16; ++j) { const unsigned c = xb_ld(&bar[XB_XCNT(j)]); sum += c; cnt += (c > 0u) ? 1u : 0u; }
        mine = xb_ld(&bar[XB_XCNT(x)]);
        if (sum == G) break;
        __builtin_amdgcn_s_sleep(1);
        if ((++sp & 255u) == 0u) { if (xb_ld(&bar[XB_TMO])) break; if (sp > XB_SPIN_CAP) { atomicAdd(&bar[XB_TMO], 1u); break; } }
    }
    nloc = mine > 0u ? mine : 1u; nx = cnt > 0u ? cnt : 1u;
}
__device__ __forceinline__ void xcd_barrier(volatile LAS unsigned* st) {
    asm volatile("s_waitcnt vmcnt(0)" ::: "memory");
    __syncthreads();
    if (opaque_tid() == 0) {
        unsigned* bar = (unsigned*)(*(volatile LAS unsigned long long*)(st + 4));
        const unsigned x = st[2];
        __builtin_amdgcn_s_waitcnt(0);
        unsigned nloc = st[0], nx = st[1];
        if (nloc == 0u) { xcd_barrier_complete(bar, x, nloc, nx); st[0] = nloc; st[1] = nx; }
        const unsigned g = st[3]; st[3] = g + 1u;
        const unsigned old = xb_add(&bar[XB_XSUB(x)], 1u);
        if (old + 1u == (g + 1u) * nloc) {
            __builtin_amdgcn_fence(__ATOMIC_RELEASE, "agent");
            asm volatile("s_waitcnt vmcnt(0)" ::: "memory");
            const unsigned og = xb_add(&bar[XB_TOP], 1u);
            if (og + 1u == (g + 1u) * nx) (void)__hip_atomic_fetch_add(&bar[XB_TOPGEN], 1u, __ATOMIC_RELAXED, __HIP_MEMORY_SCOPE_AGENT);
        }
        XB_SPIN(xb_ld(&bar[XB_TOPGEN]) <= g, bar);
        __builtin_amdgcn_fence(__ATOMIC_ACQUIRE, "agent");
        asm volatile("s_waitcnt vmcnt(0)" ::: "memory");
    }
    __syncthreads();
}

constexpr int BM = 256, BK = 64, HALF = 128, HTB = HALF * BK * 2, NXCD = 8, WGM = 4;
__device__ __forceinline__ int lds_byte(int r, int c) { const int st = (r >> 4) * 2 + (c >> 5), rr = r & 15, cc = c & 31, ob = rr * 64 + cc * 2; return st * 1024 + (ob ^ (((ob >> 9) & 1) << 5)); }
__device__ __forceinline__ void stage_rc(int b, int& R, int& C) { const int st = b / 1024, sb = b % 1024, swz = sb ^ (((sb >> 9) & 1) << 5); R = (st >> 1) * 16 + swz / 64; C = (st & 1) * 32 + (swz % 64) / 2; }

enum { E_GU = 0, E_RESID = 1, E_WIN = 2, E_GATES = 3, E_PROJ = 4 };
struct GemmDesc {
    const bf16_t* A; const bf16_t* Bt;
    int lda, ldb, nM, nN, nt, kmode;
    int emode, sub;
    float alpha;
    const float* ss;
    bf16_t* o16;
    float* o32;
    const float* hsrc;
    float* ssn;
    const float* v0; const float* v1; const float* v2;
    const bf16_t* pp;
    bf16_t* o16b;
    int op, layer;
    int n2, daddr2;
};
struct Unit { int pm, pn, nt, daddr; const char* cA; const char* cB; };

__device__ __forceinline__ int rfl(int v) { return __builtin_amdgcn_readfirstlane(v); }
__device__ __forceinline__ const char* rfl_ptr(const char* p) { const unsigned long long u = (unsigned long long)p; const unsigned lo = (unsigned)__builtin_amdgcn_readfirstlane((int)(unsigned)u), hi = (unsigned)__builtin_amdgcn_readfirstlane((int)(unsigned)(u >> 32)); return (const char*)(((unsigned long long)hi << 32) | lo); }
typedef const LAS GemmDesc* DescP;
__device__ __forceinline__ DescP opaque_desc(int daddr) { unsigned a = (unsigned)daddr; asm volatile("" : "+v"(a)); return (DescP)a; }
__device__ __forceinline__ bool unit_next(int daddr, int i, int G, int c, Unit& u) {
    DescP d = opaque_desc(daddr);
    int nM = rfl(d->nM), nN = rfl(d->nN), nwg = nM * nN;
    const int n2 = rfl(d->n2);
    if (c >= nwg) return false;
    const int rem = nwg % G, np = (nwg - c + G - 1) / G;
    long L;
    u.daddr = daddr;
    if (i < np) L = (long)i * G + c;
    else {
        if (n2 == 0 || c < rem) return false;
        L = (long)(c - rem) + (long)(i - np) * (G - rem); if (L >= n2) return false;
        u.daddr = rfl(d->daddr2); d = opaque_desc(u.daddr); nM = rfl(d->nM); nN = rfl(d->nN); nwg = nM * nN;
    }
    int wgid = (int)L; { const int q = nwg / NXCD, r = nwg % NXCD, xcd = wgid % NXCD, off = wgid / NXCD; wgid = (xcd < r ? xcd * (q + 1) : r * (q + 1) + (xcd - r) * q) + off; }
    const int nig = WGM * nN, gid = wgid / nig, fm = gid * WGM, gsz = (nM - fm) < WGM ? (nM - fm) : WGM;
    u.pm = fm + ((wgid % nig) % gsz); u.pn = (wgid % nig) / gsz;
    const int kmode = rfl(d->kmode), lda = rfl(d->lda), ldb = rfl(d->ldb);
    int koffA = 0, koffB = 0, nt = rfl(d->nt);
    if (kmode == 1) { koffA = u.pn * 256; }
    else if (kmode == 2) {
        const int c0 = u.pn * 128, h0 = c0 / 80, h1 = (c0 + 127) / 80;
        int k0 = (h0 * 80) & ~63; int k1 = ((h1 + 1) * 80 + 63) & ~63; if (k1 > R_) k1 = R_;
        nt = (k1 - k0) / 64; if (nt & 1) { ++nt; if (k0 + nt * 64 > R_) k0 = R_ - nt * 64; }
        koffA = k0; koffB = k0;
    }
    u.nt = nt;
    u.cA = rfl_ptr((const char*)d->A + ((size_t)u.pm * 256 * lda + koffA) * 2);
    u.cB = rfl_ptr((const char*)d->Bt + ((size_t)u.pn * 256 * ldb + koffB) * 2);
    return true;
}

__device__ __forceinline__ float gelu_tanh(float x) { const float t = x + 0.044715f * x * x * x; return x * __builtin_amdgcn_rcpf(1.0f + __expf(-1.5957691216f * t)); }

__device__ __forceinline__ void epilogue(int daddr, f32x4 (&acc)[2][2][4][2], int pm, int pn, int wr, int wc, int fr, int fq, int& rs_tag) {
    DescP dl = opaque_desc(daddr);
    int tid_e;
    { const int t_ = opaque_tid(); tid_e = t_; const int w_ = __builtin_amdgcn_readfirstlane(t_ >> 6), l_ = t_ & 63; wr = w_ >> 2; wc = w_ & 3; fr = l_ & 15; fq = l_ >> 4; }
    const int emode = rfl(dl->emode);
    const int row0 = pm * BM + wr * 64 + fr;
    const int cw = wc * 32 + fq * 4;
    float rsv[8];
    {
        const float* ssp = dl->ss;
        LAS float* rsc = (LAS float*)(unsigned)(LDS_RSC) + tid_e;
        if (ssp) {
            if (rs_tag != pm) {
#pragma unroll
                for (int i = 0; i < 8; ++i) rsv[i] = ss_get(ssp, row0 + (i >> 2) * HALF + (i & 3) * 16);
#pragma unroll
                for (int i = 0; i < 8; ++i) { rsv[i] = rsqrtf(rsv[i] * (1.0f / D_) + EPS_); rsc[i * 512] = rsv[i]; }
                rs_tag = pm;
            } else {
#pragma unroll
                for (int i = 0; i < 8; ++i) rsv[i] = rsc[i * 512];
            }
        } else {
#pragma unroll
            for (int i = 0; i < 8; ++i) rsv[i] = 1.0f;
        }
    }
    if (emode == E_GU) {
        bf16_t* const o16 = dl->o16;
#pragma unroll
        for (int ai = 0; ai < 2; ++ai)
#pragma unroll
            for (int m = 0; m < 4; ++m) {
                const int row = row0 + ai * HALF + m * 16;
                const float rs = rsv[ai * 4 + m];
                bf16_t* op = o16 + (size_t)row * F_ + pn * 128 + wc * 32 + fq * 8;
                u32x4 w4;
#pragma unroll
                for (int n = 0; n < 2; ++n) {
                    const f32x4 g = acc[ai][0][m][n] * rs, u = acc[ai][1][m][n] * rs;
                    float o[4];
#pragma unroll
                    for (int j = 0; j < 4; ++j) o[j] = 1.0f + __expf(-fmaxf(g[j], -20.0f));
                    {
                        const float p01 = o[0] * o[1], p23 = o[2] * o[3], r = __builtin_amdgcn_rcpf(p01 * p23), r23 = r * p23, r01 = r * p01;
                        const float s0 = r23 * o[1], s1 = r23 * o[0], s2 = r01 * o[3], s3 = r01 * o[2];
                        o[0] = g[0] * s0 * u[0]; o[1] = g[1] * s1 * u[1]; o[2] = g[2] * s2 * u[2]; o[3] = g[3] * s3 * u[3];
                    }
                    if (n == 0) { w4.x = pk2(o[0], o[1]); w4.y = pk2(o[2], o[3]); } else { w4.z = pk2(o[0], o[1]); w4.w = pk2(o[2], o[3]); }
                }
                *(u32x4*)op = w4;
                asm volatile("" ::: "memory");
            }
    } else if (emode == E_RESID) {
        const int sub = rfl(dl->sub); const float alpha = dl->alpha;
        const bf16_t* const h16 = (const bf16_t*)dl->hsrc; bf16_t* const o16 = dl->o16; float* const ssn = dl->ssn; const bf16_t* const pp = dl->pp;
        const int cwp = wc * 32 + fq * 8;
#pragma unroll
        for (int ai = 0; ai < 2; ++ai) {
            u32x4 hv[4][2];
#pragma unroll
            for (int mm = 0; mm < 4; ++mm) {
                const size_t off = (size_t)(row0 + ai * HALF + mm * 16) * D_ + pn * 256 + cwp;
#pragma unroll
                for (int bj = 0; bj < 2; ++bj) hv[mm][bj] = *(const u32x4*)(h16 + off + bj * HALF);
            }
#pragma unroll
            for (int m = 0; m < 4; ++m) {
                const int row = row0 + ai * HALF + m * 16;
                const size_t off = (size_t)row * D_ + pn * 256 + cwp;
                const float rs = rsv[ai * 4 + m];
                float q = 0.f;
#pragma unroll
                for (int bj = 0; bj < 2; ++bj) {
                    const size_t o2 = off + bj * HALF;
                    u32x4 p4 = (u32x4){0u, 0u, 0u, 0u};
                    if (sub == 2) p4 = *(const u32x4*)(pp + o2);
                    const u32x4 h4 = hv[m][bj];
                    u32x4 w4;
#pragma unroll
                    for (int n = 0; n < 2; ++n) {
                        f32x4 v = acc[ai][bj][m][n];
                        if (sub == 0) v = v * alpha;
                        else if (sub == 1) { const int col = pn * 256 + cwp + bj * HALF + 4 * n; v = (v + *(const f32x4*)(dl->v0 + col)) * *(const f32x4*)(dl->v1 + col); }
                        else { const unsigned pa = n ? p4.z : p4.x, pb = n ? p4.w : p4.y;
                            v[0] = fsigmoid(v[0] * rs) * bf_lo(pa); v[1] = fsigmoid(v[1] * rs) * bf_hi(pa);
                            v[2] = fsigmoid(v[2] * rs) * bf_lo(pb); v[3] = fsigmoid(v[3] * rs) * bf_hi(pb); }
                        const unsigned ha = n ? h4.z : h4.x, hb_ = n ? h4.w : h4.y;
                        const f32x4 hn = (f32x4){bf_lo(ha), bf_hi(ha), bf_lo(hb_), bf_hi(hb_)} + v;
                        if (n == 0) { w4.x = pk2(hn[0], hn[1]); w4.y = pk2(hn[2], hn[3]); } else { w4.z = pk2(hn[0], hn[1]); w4.w = pk2(hn[2], hn[3]); }
                        q += (hn[0] * hn[0] + hn[1] * hn[1]) + (hn[2] * hn[2] + hn[3] * hn[3]);
                    }
                    *(u32x4*)(o16 + o2) = w4;
                }
                q += __shfl_xor(q, 16); q += __shfl_xor(q, 32);
                if (fq == 0) atomicAdd((u64*)ssn + row, (u64)(q * SS_FX));
            }
            asm volatile("" ::: "memory");
        }
    } else if (emode == E_WIN) {
        bf16_t* const o16 = dl->o16;
        const bool isg = pn < 5;
        const int cwp = wc * 32 + fq * 8;
#pragma unroll
        for (int ai = 0; ai < 2; ++ai)
#pragma unroll
            for (int m = 0; m < 4; ++m) {
                const int row = row0 + ai * HALF + m * 16;
                const float rs = rsv[ai * 4 + m];
                const size_t off = (size_t)row * (2 * R_) + pn * 256 + cwp;
#pragma unroll
                for (int bj = 0; bj < 2; ++bj) {
                    u32x4 w4;
#pragma unroll
                    for (int n = 0; n < 2; ++n) {
                        f32x4 v = acc[ai][bj][m][n] * rs;
                        if (isg) { v[0] = gelu_tanh(v[0]); v[1] = gelu_tanh(v[1]); v[2] = gelu_tanh(v[2]); v[3] = gelu_tanh(v[3]); }
                        if (n == 0) { w4.x = pk2(v[0], v[1]); w4.y = pk2(v[2], v[3]); } else { w4.z = pk2(v[0], v[1]); w4.w = pk2(v[2], v[3]); }
                    }
                    *(u32x4*)(o16 + off + bj * HALF) = w4;
                }
                asm volatile("" ::: "memory");
            }
    } else if (emode == E_GATES) {
        const float* const v0 = dl->v0; const float* const v1 = dl->v1; const float* const v2 = dl->v2; const bf16_t* const pp = dl->pp; bf16_t* const o16 = dl->o16; bf16_t* const o16b = dl->o16b;
        const int c0 = pn * 128 + wc * 32 + fq * 8;
        u32x4 xw[8];
#pragma unroll
        for (int i = 0; i < 8; ++i) xw[i] = *(const u32x4*)(pp + (size_t)(row0 + (i >> 2) * HALF + (i & 3) * 16) * R_ + c0);
        f32x4 ba[2], bx[2], sp8[2];
#pragma unroll
        for (int n = 0; n < 2; ++n) {
            ba[n] = *(const f32x4*)(v0 + c0 + 4 * n); bx[n] = *(const f32x4*)(v1 + c0 + 4 * n);
            const f32x4 ap = *(const f32x4*)(v2 + c0 + 4 * n);
#pragma unroll
            for (int j = 0; j < 4; ++j) {
                const float z = -ap[j], e = __expf(-fabsf(z));
                const float l1p = (e < 0.03125f) ? e * (1.0f - e * (0.5f - e * (0.33333333f - 0.25f * e))) : __logf(1.0f + e);
                sp8[n][j] = 8.0f * (fmaxf(z, 0.f) + l1p);
            }
        }
#pragma unroll
        for (int ai = 0; ai < 2; ++ai)
#pragma unroll
            for (int m = 0; m < 4; ++m) {
                const int row = row0 + ai * HALF + m * 16;
                const size_t idx = (size_t)row * R_ + c0;
                const u32x4 x4 = xw[ai * 4 + m];
                u32x4 wl, wb;
#pragma unroll
                for (int n = 0; n < 2; ++n) {
                    const unsigned xa = n ? x4.z : x4.x, xb_ = n ? x4.w : x4.y;
                    const float xc[4] = {bf_lo(xa), bf_hi(xa), bf_lo(xb_), bf_hi(xb_)};
                    const f32x4 ar = acc[ai][0][m][n] + ba[n], ax = acc[ai][1][m][n] + bx[n];
                    float la[4], bv[4];
#pragma unroll
                    for (int j = 0; j < 4; ++j) {
                        const float r = fsigmoid(ar[j]), ig = fsigmoid(ax[j]);
                        la[j] = -sp8[n][j] * r;
                        const float y = 2.0f * la[j];
                        const float om = (y > -0.0625f) ? -y * (1.0f + y * (0.5f + y * (0.16666667f + y * 0.041666668f))) : 1.0f - __expf(y);
                        bv[j] = sqrtf(om) * ig * xc[j];
                    }
                    if (n == 0) { wl.x = pk2(la[0], la[1]); wl.y = pk2(la[2], la[3]); wb.x = pk2(bv[0], bv[1]); wb.y = pk2(bv[2], bv[3]); }
                    else { wl.z = pk2(la[0], la[1]); wl.w = pk2(la[2], la[3]); wb.z = pk2(bv[0], bv[1]); wb.w = pk2(bv[2], bv[3]); }
                }
                *(u32x4*)(o16 + idx) = wl;
                *(u32x4*)(o16b + idx) = wb;
                asm volatile("" ::: "memory");
            }
    } else {
        bf16_t* const o16 = dl->o16;
        const int cwp = wc * 32 + fq * 8;
#pragma unroll
        for (int ai = 0; ai < 2; ++ai)
#pragma unroll
            for (int m = 0; m < 4; ++m) {
                const int row = row0 + ai * HALF + m * 16;
                const size_t off = (size_t)row * D_ + pn * 256 + cwp;
#pragma unroll
                for (int bj = 0; bj < 2; ++bj) {
                    const f32x4 v0_ = acc[ai][bj][m][0], v1_ = acc[ai][bj][m][1];
                    u32x4 w4; w4.x = pk2(v0_[0], v0_[1]); w4.y = pk2(v0_[2], v0_[3]); w4.z = pk2(v1_[0], v1_[1]); w4.w = pk2(v1_[2], v1_[3]);
                    *(u32x4*)(o16 + off + bj * HALF) = w4;
                }
                asm volatile("" ::: "memory");
            }
    }
}

__device__ __forceinline__ void gemm_phase(LAS unsigned char* lds, int daddr, int G, int cidx, unsigned long long& tk) {
    daddr = opaque_s(daddr); DescP d = opaque_desc(daddr);
    const int tid = opaque_tid(), wid = __builtin_amdgcn_readfirstlane(tid >> 6), lane = tid & 63, wr = wid >> 2, wc = wid & 3, fr = lane & 15, fq = lane >> 4;
    G = opaque_s(G); cidx = opaque_s(cidx);
    unsigned voffA[2];
#pragma unroll
    for (int i = 0; i < 2; ++i) { int R, C; stage_rc(tid * 16 + i * 8192, R, C);
        voffA[i] = (unsigned)(R * rfl(d->lda) + C) * 2u; }
#define voffB voffA
    const size_t kstep = (size_t)(BK * 2);
    const size_t hstepA = (size_t)HALF * rfl(d->lda) * 2;
#define hstepB hstepA
    const unsigned ldsw = (unsigned)wid * 1024u;
    const int aoff = lds_byte(wr * 64 + fr, fq * 8), boff = lds_byte(wc * 32 + fr, fq * 8);
#define PG8_SA(b, h) (((b) * 2 + (h)) * HTB)
#define PG8_SB(b, h) ((4 + (b) * 2 + (h)) * HTB)
#define PG8_STAGE(bufoff, gbase, voff) do { _Pragma("unroll") for (int _i = 0; _i < 2; ++_i) \
        __builtin_amdgcn_global_load_lds((const unsigned*)((const char*)(gbase) + (voff)[_i]), (LAS unsigned*)(lds + (bufoff) + ldsw + _i * 8192), 16, 0, 0); } while (0)
#define PG8_LDA(dst, b, h) do { _Pragma("unroll") for (int m = 0; m < 4; ++m) _Pragma("unroll") for (int k = 0; k < 2; ++k) dst[m][k] = *(const LAS bf16x8*)(lds + PG8_SA(b, h) + aoff + m * 2048 + k * 1024); } while (0)
#define PG8_LDB(dst, b, h) do { _Pragma("unroll") for (int n = 0; n < 2; ++n) _Pragma("unroll") for (int k = 0; k < 2; ++k) dst[n][k] = *(const LAS bf16x8*)(lds + PG8_SB(b, h) + boff + n * 2048 + k * 1024); } while (0)
#define PG8_MMA(ai, bj, At, Bt) do { __builtin_amdgcn_s_setprio(1); _Pragma("unroll") for (int m = 0; m < 4; ++m) _Pragma("unroll") for (int n = 0; n < 2; ++n) _Pragma("unroll") for (int k = 0; k < 2; ++k) \
        acc[ai][bj][m][n] = __builtin_amdgcn_mfma_f32_16x16x32_bf16(Bt[n][k], At[m][k], acc[ai][bj][m][n], 0, 0, 0); __builtin_amdgcn_s_setprio(0); } while (0)
#define PG8_WAIT_V(n) asm volatile("s_waitcnt vmcnt(" #n ")" ::: "memory")
#define PG8_WAIT_L(n) asm volatile("s_waitcnt lgkmcnt(" #n ")" ::: "memory")
#define PG8_BAR __builtin_amdgcn_s_barrier()
#define PG8_SCHED __builtin_amdgcn_sched_barrier(0)
    Unit cur, nxt; int ui = 0; int rs_tag = -1;
    if (!unit_next(daddr, 0, G, cidx, cur)) return;
    f32x4 acc[2][2][4][2];
#pragma unroll
    for (int a = 0; a < 2; ++a)
#pragma unroll
        for (int b = 0; b < 2; ++b)
#pragma unroll
            for (int m = 0; m < 4; ++m)
#pragma unroll
                for (int n = 0; n < 2; ++n) acc[a][b][m][n] = (f32x4){0.f, 0.f, 0.f, 0.f};
    bf16x8 At[4][2], B0[2][2], B1[2][2];
    const char* cA = cur.cA; const char* cB = cur.cB;
    PG8_STAGE(PG8_SB(0, 0), cB, voffB); PG8_STAGE(PG8_SA(0, 0), cA, voffA); PG8_STAGE(PG8_SB(0, 1), cB + hstepB, voffB); PG8_STAGE(PG8_SA(0, 1), cA + hstepA, voffA);
    if (wr == 1) PG8_BAR;
    PG8_WAIT_V(4); PG8_BAR;
    PG8_STAGE(PG8_SB(1, 0), cB + kstep, voffB); PG8_STAGE(PG8_SA(1, 0), cA + kstep, voffA); PG8_STAGE(PG8_SB(1, 1), cB + hstepB + kstep, voffB);
    PG8_WAIT_V(6); PG8_BAR;
    for (;;) {
        const bool has_next = unit_next(daddr, ui + 1, G, cidx, nxt);
        const char* nA = has_next ? nxt.cA : cA; const char* nB = has_next ? nxt.cB : cB;
        const int nt = cur.nt;
        unsigned long long tk0 = 0; if ((TMASK >> 18) & 1) tk0 = ((TMASK >> 19) & 1) ? __builtin_amdgcn_s_memtime() : __builtin_amdgcn_s_memrealtime();
        for (int t = 0; t < nt; t += 2) {
            const bool last = (t == nt - 2);
            const char* a1 = cA + (size_t)(t + 1) * kstep;
            const char* a2 = last ? nA : cA + (size_t)(t + 2) * kstep; const char* b2 = last ? nB : cB + (size_t)(t + 2) * kstep;
            const char* a3 = a2 + kstep; const char* b3 = b2 + kstep;
            PG8_LDB(B0, 0, 0); PG8_SCHED; PG8_LDA(At, 0, 0); PG8_STAGE(PG8_SA(1, 1), a1 + hstepA, voffA);
            PG8_WAIT_L(8); PG8_BAR; PG8_WAIT_L(0); PG8_MMA(0, 0, At, B0); PG8_BAR; PG8_SCHED;
            PG8_LDB(B1, 0, 1); PG8_STAGE(PG8_SB(0, 0), b2, voffB);
            PG8_BAR; PG8_WAIT_L(0); PG8_MMA(0, 1, At, B1); PG8_BAR;
            PG8_LDA(At, 0, 1); PG8_STAGE(PG8_SA(0, 0), a2, voffA);
            PG8_BAR; PG8_WAIT_L(0); PG8_MMA(1, 0, At, B0); PG8_BAR; PG8_SCHED;
            PG8_STAGE(PG8_SB(0, 1), b2 + hstepB, voffB);
            PG8_WAIT_V(6); PG8_BAR; PG8_MMA(1, 1, At, B1); PG8_BAR;
            PG8_LDB(B0, 1, 0); PG8_SCHED; PG8_LDA(At, 1, 0); PG8_STAGE(PG8_SA(0, 1), a2 + hstepA, voffA);
            PG8_WAIT_L(8); PG8_BAR; PG8_WAIT_L(0); PG8_MMA(0, 0, At, B0); PG8_BAR; PG8_SCHED;
            PG8_LDB(B1, 1, 1); PG8_STAGE(PG8_SB(1, 0), b3, voffB);
            PG8_BAR; PG8_WAIT_L(0); PG8_MMA(0, 1, At, B1); PG8_BAR;
            PG8_LDA(At, 1, 1); PG8_STAGE(PG8_SA(1, 0), a3, voffA);
            PG8_BAR; PG8_WAIT_L(0); PG8_MMA(1, 0, At, B0); PG8_BAR; PG8_SCHED;
            PG8_STAGE(PG8_SB(1, 1), b3 + hstepB, voffB);
            PG8_WAIT_V(6); PG8_BAR; PG8_MMA(1, 1, At, B1); PG8_BAR;
        }
        if ((TMASK >> 18) & 1) tk += (((TMASK >> 19) & 1) ? __builtin_amdgcn_s_memtime() : __builtin_amdgcn_s_memrealtime()) - tk0;
        epilogue(cur.daddr, acc, cur.pm, cur.pn, wr, wc, fr, fq, rs_tag);
        if (!has_next) break;
#pragma unroll
        for (int a = 0; a < 2; ++a)
#pragma unroll
            for (int b = 0; b < 2; ++b)
#pragma unroll
                for (int m = 0; m < 4; ++m)
#pragma unroll
                    for (int n = 0; n < 2; ++n) acc[a][b][m][n] = (f32x4){0.f, 0.f, 0.f, 0.f};
        cur = nxt; cA = nA; cB = nB; ++ui;
    }
    PG8_WAIT_V(0);
    if (wr == 0) PG8_BAR;
    PG8_BAR;
#undef voffB
#undef hstepB
#undef PG8_SA
#undef PG8_SB
#undef PG8_STAGE
#undef PG8_LDA
#undef PG8_LDB
#undef PG8_MMA
#undef PG8_WAIT_V
#undef PG8_WAIT_L
#undef PG8_BAR
#undef PG8_SCHED
}

typedef const LAS Params* PLp;
__device__ __forceinline__ PLp opaque_pl() { unsigned a = LDS_PL; asm volatile("" : "+v"(a)); return (PLp)a; }
__device__ __forceinline__ void tr_item(const float* W, int K, int N, bf16_t* WT, int ldt, int gumode, int guoff, const float* scale, int item, int lane) {
    const int nkb = K / 16, nb = item / nkb, kb = item - nb * nkb, k0 = 16 * kb, n0 = 256 * nb;
    const float* src = W + (size_t)k0 * N + n0 + 4 * lane;
    f32x4 v[16];
#pragma unroll
    for (int i = 0; i < 16; ++i) v[i] = __builtin_nontemporal_load((const f32x4*)(src + (size_t)i * N));
    if (scale) {
#pragma unroll
        for (int i = 0; i < 16; ++i) v[i] = v[i] * scale[k0 + i];
    }
#pragma unroll
    for (int e = 0; e < 4; ++e) {
        const int n = n0 + 4 * lane + e;
        const int w5 = n & 31, rho = 16 * ((w5 >> 2) & 1) + 4 * (w5 >> 3) + (w5 & 3);
        const int row = gumode ? ((n >> 7) * 256 + guoff + ((n & 127) & ~31) + rho) : ((n & ~31) + rho);
        u32x4 o0, o1;
        o0.x = pk2(v[0][e], v[1][e]); o0.y = pk2(v[2][e], v[3][e]); o0.z = pk2(v[4][e], v[5][e]); o0.w = pk2(v[6][e], v[7][e]);
        o1.x = pk2(v[8][e], v[9][e]); o1.y = pk2(v[10][e], v[11][e]); o1.z = pk2(v[12][e], v[13][e]); o1.w = pk2(v[14][e], v[15][e]);
        bf16_t* dst = WT + (size_t)row * ldt + k0;
        *(u32x4*)dst = o0; *(u32x4*)(dst + 8) = o1;
    }
}

__device__ __forceinline__ void prep_layer(PLp P, int layer, size_t wloff, LAS unsigned char* lds, int widx, int nworkers, int part) {
    P = opaque_pl(); unsigned char* wl = P->ws + wloff;
    const int tid = opaque_tid(), lane = tid & 63, wave = __builtin_amdgcn_readfirstlane(tid >> 6); widx = opaque_s(widx); nworkers = opaque_s(nworkers);
    LAS float* scr = (LAS float*)(lds + wave * 8448);
    const int gw = widx * NWAVES + wave, NGW = nworkers * NWAVES;
    const int jl = layer >> 1; const bool lru = (layer & 1) == 0;
    constexpr int I_GU = (D_ / 16) * (F_ / 256), I_DN = (F_ / 16) * (D_ / 256), I_PGt = (D_ / 16) * (D_ / 256);
    constexpr int I_WIN = (D_ / 16) * (2 * R_ / 256), I_WOUT = (R_ / 16) * (D_ / 256), I_POOL = 4 * (256 / 16);
    const int nmix = lru ? (I_WIN + I_WOUT) : I_POOL;
    const int NITEMS = 6 * I_GU + I_PGt + nmix;
    static_assert(I_GU == I_DN, "items");
    const int H = ((NITEMS * 27) / 32) & ~3;
    const int it0 = (part == 1) ? H : 0, it1 = (part == 0) ? H : NITEMS;
    const size_t WFF = (size_t)D_ * F_;
    for (int it = it0 + gw; it < it1; it += NGW) {
        int r = it;
        const float* W; int K, N; bf16_t* WT; int gumode = 0, guoff = 0, ldt = 0; const float* scale = nullptr;
        if (r < 3 * I_GU) {
            const int which = r / I_GU; r -= which * I_GU;
            if (which < 2) { W = P->in[which ? I_F1U : I_F1G] + layer * WFF; K = D_; N = F_; WT = (bf16_t*)(wl + WL_GU1); gumode = 1; guoff = which * 128; scale = P->in[I_F1N] + layer * D_; }
            else { W = P->in[I_F1D] + layer * WFF; K = F_; N = D_; WT = (bf16_t*)(wl + WL_D1); }
        } else if (r < 6 * I_GU) {
            r -= 3 * I_GU; const int which = r / I_GU; r -= which * I_GU;
            if (which < 2) { W = P->in[which ? I_F2U : I_F2G] + layer * WFF; K = D_; N = F_; WT = (bf16_t*)(wl + WL_GU2); gumode = 1; guoff = which * 128; scale = P->in[I_F2N] + layer * D_; }
            else { W = P->in[I_F2D] + layer * WFF; K = F_; N = D_; WT = (bf16_t*)(wl + WL_D2); }
        } else {
            r -= 6 * I_GU;
            if (r < I_PGt) { W = P->in[I_PLG] + (size_t)layer * D_ * D_; K = D_; N = D_; WT = (bf16_t*)(wl + WL_PG); scale = P->in[I_PLN] + layer * D_; }
            else {
                r -= I_PGt;
                if (lru) {
                    if (r < I_WIN) { W = P->in[I_LWIN] + (size_t)jl * D_ * 2 * R_; K = D_; N = 2 * R_; WT = (bf16_t*)(wl + WL_WIN); scale = P->in[I_MIXN] + layer * D_; }
                    else { r -= I_WIN; W = P->in[I_LWOUT] + (size_t)jl * R_ * D_; K = R_; N = D_; WT = (bf16_t*)(wl + WL_WOUT); }
                } else {
                    const int g = r / 16; r = r % 16;
                    W = P->in[I_PW] + ((size_t)jl * 4 + g) * 256 * 256; K = 256; N = 256; ldt = D_; WT = (bf16_t*)(wl + WL_MIX) + (size_t)g * 256 * D_; scale = P->in[I_MIXN] + layer * D_ + g * 256;
                }
            }
        }
        K = opaque_s(rfl(K)); N = opaque_s(rfl(N));
        tr_item(W, K, N, WT, ldt ? ldt : K, gumode, guoff, scale, r, lane);
    }
    if (lru && part != 1) {
        const int gt = widx * NTHR + tid, NGT = nworkers * NTHR;
        const float* wa = P->in[I_LWA] + (size_t)jl * 16 * 80 * 80; const float* wx = P->in[I_LWX] + (size_t)jl * 16 * 80 * 80;
        bf16_t* dst = (bf16_t*)(wl + WL_WG);
        for (int i = gt; i < 2 * R_ * (R_ / 8); i += NGT) {
            const int row = i / (R_ / 8), k8 = (i % (R_ / 8)) * 8;
            const int t = row >> 8, w = row & 255; const bool isI = w >= 128; const int rho = w & 31, p32 = 8 * ((rho & 15) >> 2) + 4 * (rho >> 4) + (rho & 3);
            const int c = t * 128 + ((w & 127) & ~31) + p32, h = c / 80, j = c % 80;
            const float* src = (isI ? wx : wa) + (size_t)h * 80 * 80 + j;
            float v[8];
#pragma unroll
            for (int e = 0; e < 8; ++e) { const int k = k8 + e, ki = k - h * 80; v[e] = (ki >= 0 && ki < 80) ? src[ki * 80] : 0.f; }
            u32x4 o; o.x = pk2(v[0], v[1]); o.y = pk2(v[2], v[3]); o.z = pk2(v[4], v[5]); o.w = pk2(v[6], v[7]);
            *(u32x4*)(dst + (size_t)row * R_ + k8) = o;
        }
    }
}

__device__ __forceinline__ void prep_global(PLp P, LAS unsigned char* lds, int G) {
    P = opaque_pl();
    const int tid = opaque_tid(), lane = tid & 63, wave = __builtin_amdgcn_readfirstlane(tid >> 6); G = opaque_s(G); const int bid = opaque_bid();
    LAS float* scr = (LAS float*)(lds + wave * 8448);
    const int gw = bid * NWAVES + wave, NGW = G * NWAVES;
    bf16_t* wpp = (bf16_t*)(P->ws + OFF_WPPALL);
    constexpr int I_PPt = (PLE_ / 16) * (D_ / 256);
    for (int it = gw; it < 4 * I_PPt; it += NGW) {
        const int l = it / I_PPt, r = it % I_PPt;
        const int K = opaque_s(PLE_), N = opaque_s(D_);
        tr_item(P->in[I_PLP] + (size_t)l * PLE_ * D_, K, N, wpp + l * PLE_, D_, 0, 0, nullptr, r, lane);
    }
    const int gt = bid * NTHR + tid, NGT = G * NTHR;
    const float* src = P->in[I_P]; bf16_t* dst = (bf16_t*)(P->ws + OFF_PBALL);
    constexpr int NP8 = 4 * M_ * (PLE_ / 8);
    for (int i0 = gt; i0 < NP8; i0 += 8 * NGT) {
        f32x4 a[8], b[8];
#pragma unroll
        for (int u = 0; u < 8; ++u) { const int i = i0 + u * NGT; if (i < NP8) { a[u] = __builtin_nontemporal_load((const f32x4*)(src + (size_t)i * 8)); b[u] = __builtin_nontemporal_load((const f32x4*)(src + (size_t)i * 8 + 4)); } }
#pragma unroll
        for (int u = 0; u < 8; ++u) { const int i = i0 + u * NGT; if (i < NP8) {
            const int l = i / (M_ * (PLE_ / 8)), rem = i % (M_ * (PLE_ / 8)), row = rem / (PLE_ / 8), c8 = (rem % (PLE_ / 8)) * 8;
            u32x4 o; o.x = pk2(a[u][0], a[u][1]); o.y = pk2(a[u][2], a[u][3]); o.z = pk2(b[u][0], b[u][1]); o.w = pk2(b[u][2], b[u][3]);
            *(u32x4*)(dst + (size_t)row * D_ + l * PLE_ + c8) = o; } }
    }
}

__device__ __forceinline__ void init_phase(PLp P, int G) {
    P = opaque_pl();
    const int tid = opaque_tid(), lane = tid & 63, wave = tid >> 6; G = opaque_s(G); const int bid = opaque_bid();
    const int gw = bid * NWAVES + wave, NGW = G * NWAVES;
    float* ss = (float*)(P->ws + OFF_SS);
    bf16_t* hb = (bf16_t*)(P->ws + OFF_HB0);
    for (int row = gw; row < M_; row += 4 * NGW) {
        f32x4 v[4][4];
#pragma unroll
        for (int r = 0; r < 4; ++r) { const int rr = row + r * NGW; if (rr < M_) { const f32x4* xr = (const f32x4*)(P->in[I_X] + (size_t)rr * D_) + lane;
#pragma unroll
            for (int j = 0; j < 4; ++j) v[r][j] = __builtin_nontemporal_load(xr + 64 * j); } }
#pragma unroll
        for (int r = 0; r < 4; ++r) { const int rr = row + r * NGW; if (rr < M_) {
            u32x2* o8 = (u32x2*)(hb + (size_t)rr * D_) + lane; float s = 0.f;
#pragma unroll
            for (int j = 0; j < 4; ++j) { s += (v[r][j][0] * v[r][j][0] + v[r][j][1] * v[r][j][1]) + (v[r][j][2] * v[r][j][2] + v[r][j][3] * v[r][j][3]); u32x2 q; q.x = pk2(v[r][j][0], v[r][j][1]); q.y = pk2(v[r][j][2], v[r][j][3]); o8[64 * j] = q; }
            s = wave_sum(s);
            if (lane == 0) ((u64*)ss)[rr] = (u64)(s * SS_FX); } }
    }
    const int gt = bid * NTHR + tid, NGT = G * NTHR;
    for (int i = gt; i < 16 * M_ / 2; i += NGT) *(f32x4*)(ss + 2 * SS_STRIDE + (size_t)i * 4) = zero4();
}

__device__ __forceinline__ void final_phase(PLp P, int G) {
    P = opaque_pl();
    const int tid = opaque_tid(), lane = tid & 63, wave = tid >> 6; G = opaque_s(G);
    const int gw = opaque_bid() * NWAVES + wave, NGW = G * NWAVES;
    const float* ss = (const float*)(P->ws + OFF_SS) + 2 * 16 * SS_STRIDE;
    const f32x4* fn = (const f32x4*)P->in[I_FN] + lane;
    const bf16_t* hb1 = (const bf16_t*)(P->ws + OFF_R2);
    for (int row = gw; row < M_; row += NGW) {
        f32x4* xr = (f32x4*)(P->out + (size_t)row * D_) + lane;
        const u32x2* hr = (const u32x2*)(hb1 + (size_t)row * D_) + lane;
        const float rs = rsqrtf(ss_get(ss, row) * (1.0f / D_) + EPS_);
#pragma unroll
        for (int j = 0; j < 4; ++j) { const u32x2 hw = __builtin_nontemporal_load(hr + 64 * j); __builtin_nontemporal_store((f32x4){bf_lo(hw.x), bf_hi(hw.x), bf_lo(hw.y), bf_hi(hw.y)} * rs * fn[64 * j], xr + 64 * j); }
    }
}

__device__ __forceinline__ void conv_phase(PLp P, int jl, int G) {
    P = opaque_pl();
    G = opaque_s(G); const int tid = opaque_tid();
    const bf16_t* Z = (const bf16_t*)(P->ws + OFF_R1); bf16_t* XCb = (bf16_t*)(P->ws + OFF_R4);
    const float* cw = P->in[I_LCW] + (size_t)jl * 4 * R_; const float* cb = P->in[I_LCB] + (size_t)jl * R_;
    if (tid >= 320) return;
    const int c8 = (tid % 160) * 8, tg = tid / 160;
    float w[4][8], bb[8];
#pragma unroll
    for (int k = 0; k < 4; ++k) { const f32x4 a = *(const f32x4*)(cw + k * R_ + c8), b = *(const f32x4*)(cw + k * R_ + c8 + 4);
#pragma unroll
        for (int j = 0; j < 4; ++j) { w[k][j] = a[j]; w[k][4 + j] = b[j]; } }
    { const f32x4 a = *(const f32x4*)(cb + c8), b = *(const f32x4*)(cb + c8 + 4);
#pragma unroll
        for (int j = 0; j < 4; ++j) { bb[j] = a[j]; bb[4 + j] = b[j]; } }
    for (int it = opaque_bid(); it < M_ / 64; it += G) {
        const int row0 = it * 64 + tg * 32;
        float x3[8], x2[8], x1[8];
        u32x4 p3 = (u32x4){0u, 0u, 0u, 0u}, p2 = p3, p1 = p3;
        if ((row0 & (S_ - 1)) != 0) { p3 = *(const u32x4*)(Z + (size_t)(row0 - 3) * (2 * R_) + R_ + c8); p2 = *(const u32x4*)(Z + (size_t)(row0 - 2) * (2 * R_) + R_ + c8); p1 = *(const u32x4*)(Z + (size_t)(row0 - 1) * (2 * R_) + R_ + c8); }
#pragma unroll
        for (int j = 0; j < 4; ++j) { x3[2 * j] = bf_lo(p3[j]); x3[2 * j + 1] = bf_hi(p3[j]); x2[2 * j] = bf_lo(p2[j]); x2[2 * j + 1] = bf_hi(p2[j]); x1[2 * j] = bf_lo(p1[j]); x1[2 * j + 1] = bf_hi(p1[j]); }
#pragma unroll 8
        for (int t = 0; t < 32; ++t) {
            const u32x4 px = __builtin_nontemporal_load((const u32x4*)(Z + (size_t)(row0 + t) * (2 * R_) + R_ + c8));
            float x0[8], o[8];
#pragma unroll
            for (int j = 0; j < 4; ++j) { x0[2 * j] = bf_lo(px[j]); x0[2 * j + 1] = bf_hi(px[j]); }
#pragma unroll
            for (int j = 0; j < 8; ++j) { o[j] = bb[j] + w[0][j] * x3[j] + w[1][j] * x2[j] + w[2][j] * x1[j] + w[3][j] * x0[j]; x3[j] = x2[j]; x2[j] = x1[j]; x1[j] = x0[j]; }
            u32x4 q; q.x = pk2(o[0], o[1]); q.y = pk2(o[2], o[3]); q.z = pk2(o[4], o[5]); q.w = pk2(o[6], o[7]);
            *(u32x4*)(XCb + (size_t)(row0 + t) * R_ + c8) = q;
        }
    }
}

__device__ __forceinline__ void scan1_phase(PLp P, int G) {
    P = opaque_pl();
    G = opaque_s(G); const int tid = opaque_tid();
    const bf16_t* LA = (const bf16_t*)(P->ws + OFF_R2); const bf16_t* Bb = LA + (size_t)M_ * R_;
    float* aggP = (float*)(P->ws + OFF_AGG); float* aggH = aggP + AGG_ELEMS;
    if (tid >= 320) return;
    const int c4 = tid * 4;
    for (int bc = opaque_bid(); bc < 256; bc += G) {
        const size_t base = (size_t)bc * 64 * R_ + c4;
        f32x4 h = zero4(), sl = h;
#pragma unroll 16
        for (int t = 0; t < 64; ++t) {
            const u32x2 lw = *(const u32x2*)(LA + base + (size_t)t * R_), bw = *(const u32x2*)(Bb + base + (size_t)t * R_);
            const f32x4 la = (f32x4){bf_lo(lw.x), bf_hi(lw.x), bf_lo(lw.y), bf_hi(lw.y)}, b = (f32x4){bf_lo(bw.x), bf_hi(bw.x), bf_lo(bw.y), bf_hi(bw.y)};
            f32x4 a; a[0] = __expf(la[0]); a[1] = __expf(la[1]); a[2] = __expf(la[2]); a[3] = __expf(la[3]);
            h = a * h + b; sl += la;
        }
        f32x4 p; p[0] = __expf(sl[0]); p[1] = __expf(sl[1]); p[2] = __expf(sl[2]); p[3] = __expf(sl[3]);
        *(f32x4*)(aggP + (size_t)bc * R_ + c4) = p; *(f32x4*)(aggH + (size_t)bc * R_ + c4) = h;
    }
}
__device__ __forceinline__ void scan2_phase(PLp P, int G) {
    P = opaque_pl();
    G = opaque_s(G); const int tid = opaque_tid();
    const bf16_t* LA = (const bf16_t*)(P->ws + OFF_R2); const bf16_t* Bb = LA + (size_t)M_ * R_;
    const float* aggP = (const float*)(P->ws + OFF_AGG); const float* aggH = aggP + AGG_ELEMS;
    const bf16_t* Z = (const bf16_t*)(P->ws + OFF_R1); bf16_t* Y = (bf16_t*)(P->ws + OFF_R5);
    if (tid >= 320) return;
    const int c4 = tid * 4;
    for (int bc = opaque_bid(); bc < 256; bc += G) {
        const int chunk = bc & 127, b0 = bc - chunk;
        f32x4 h = zero4();
#pragma unroll 8
        for (int j = 0; j < chunk; ++j) { const f32x4 a = *(const f32x4*)(aggP + (size_t)(b0 + j) * R_ + c4), b = *(const f32x4*)(aggH + (size_t)(b0 + j) * R_ + c4); h = a * h + b; }
        const size_t base = (size_t)bc * 64 * R_ + c4;
#pragma unroll 8
        for (int t = 0; t < 64; ++t) {
            const size_t idx = base + (size_t)t * R_;
            const u32x2 lw = __builtin_nontemporal_load((const u32x2*)(LA + idx)), bw = __builtin_nontemporal_load((const u32x2*)(Bb + idx));
            const u32x2 gw = __builtin_nontemporal_load((const u32x2*)(Z + ((size_t)bc * 64 + t) * (2 * R_) + c4));
            const f32x4 la = (f32x4){bf_lo(lw.x), bf_hi(lw.x), bf_lo(lw.y), bf_hi(lw.y)}, b = (f32x4){bf_lo(bw.x), bf_hi(bw.x), bf_lo(bw.y), bf_hi(bw.y)};
            f32x4 a; a[0] = __expf(la[0]); a[1] = __expf(la[1]); a[2] = __expf(la[2]); a[3] = __expf(la[3]);
            h = a * h + b;
            u32x2 y; y.x = pk2(h[0] * bf_lo(gw.x), h[1] * bf_hi(gw.x)); y.y = pk2(h[2] * bf_lo(gw.y), h[3] * bf_hi(gw.y));
            *(u32x2*)(Y + idx) = y;
        }
    }
}

__device__ __forceinline__ void pool_prep_phase(PLp P, int layer, LAS unsigned char* lds, int G) {
    P = opaque_pl();
    const int tid = opaque_tid(); G = opaque_s(G);
    const bf16_t* h = (const bf16_t*)(P->ws + OFF_HB0); const float* ss = (const float*)(P->ws + OFF_SS) + (size_t)(4 * layer + 1) * SS_STRIDE * 2;
    bf16_t* U = (bf16_t*)(P->ws + OFF_R1);
    LAS float* T = (LAS float*)lds;
    for (int it = opaque_bid(); it < 1024; it += G) {
        const int tt = it >> 2, g = it & 3, W = 2 << g, base = tt * 64, tl0 = base & (S_ - 1);
        {
            const int c4 = tid & 63, rq = tid >> 6;
            u32x2 hw[10]; float rsr[10];
#pragma unroll
            for (int j = 0; j < 10; ++j) {
                const int s = 16 - W + rq + 8 * j, rel = s - 15;
                hw[j] = (u32x2){0u, 0u}; rsr[j] = 0.f;
                if (s < 79 && tl0 + rel >= 0) { const int row = base + rel; hw[j] = *(const u32x2*)(h + (size_t)row * D_ + g * 256 + c4 * 4); rsr[j] = ss_get(ss, row); }
            }
#pragma unroll
            for (int j = 0; j < 10; ++j) {
                const int s = 16 - W + rq + 8 * j;
                if (s < 79) { const float rs = rsqrtf(rsr[j] * (1.0f / D_) + EPS_);
                    *(LAS f32x4*)(T + s * 256 + c4 * 4) = (f32x4){bf_lo(hw[j].x), bf_hi(hw[j].x), bf_lo(hw[j].y), bf_hi(hw[j].y)} * rs; }
            }
        }
        __syncthreads();
        {
            const int c4 = tid & 63, tq = tid >> 6;
#pragma unroll 2
            for (int j = 0; j < 8; ++j) {
                const int tl = tq + 8 * j, tloc = tl0 + tl;
                const int cnt = (tloc + 1 < W) ? (tloc + 1) : W;
                const f32x4 cur = *(const LAS f32x4*)(T + (tl + 15) * 256 + c4 * 4);
                f32x4 sum = cur;
                for (int s = 1; s < W; ++s) sum += *(const LAS f32x4*)(T + (tl + 15 - s) * 256 + c4 * 4);
                const f32x4 u = sum * (1.0f / (float)cnt) - cur;
                u32x2 w; w.x = pk2(u[0], u[1]); w.y = pk2(u[2], u[3]);
                *(u32x2*)(U + (size_t)(base + tl) * D_ + g * 256 + c4 * 4) = w;
            }
        }
        __syncthreads();
    }
}

__device__ __forceinline__ void build_table(PLp PL, LAS GemmDesc* tab) {
    unsigned char* ws = PL->ws; float* out = PL->out;
    float* SS = (float*)(ws + OFF_SS);
    bf16_t* HB0 = (bf16_t*)(ws + OFF_HB0);
    bf16_t* HB1 = (bf16_t*)(ws + OFF_R2);
    for (int step = 0; step < 40; ++step) {
        int layer, s, op;
        if (step >= 36) { layer = step - 36; op = 10; }
        else {
            if (step < 11) { layer = 0; s = step; } else if (step < 18) { layer = 1; s = step - 11; } else if (step < 29) { layer = 2; s = step - 18; } else { layer = 3; s = step - 29; }
            if (layer & 1) op = (s < 2) ? s : (s < 4 ? s + 10 : (s < 6 ? s + 4 : 11));
            else op = (s < 10) ? s : 11;
        }
        const int jl = layer >> 1;
        unsigned char* wl = ws + ((layer & 1) ? OFF_WL1 : OFF_WL0);
        LAS GemmDesc& d = tab[step];
        d.op = op; d.layer = layer; d.n2 = 0; d.daddr2 = 0;
        d.A = nullptr; d.Bt = nullptr; d.lda = 0; d.ldb = 0; d.nN = 0; d.nt = 0; d.emode = 0;
        d.nM = M_ / 256; d.kmode = 0; d.sub = 0; d.alpha = 1.0f;
        d.ss = nullptr; d.o16 = nullptr; d.o32 = nullptr; d.hsrc = nullptr; d.ssn = nullptr; d.v0 = nullptr; d.v1 = nullptr; d.v2 = nullptr; d.pp = nullptr; d.o16b = nullptr;
        if (op == 0 || op == 8) {
            const bool first = (op == 0);
            d.A = first ? (layer == 0 ? HB0 : HB1) : HB0; d.lda = D_;
            d.Bt = (const bf16_t*)(wl + (first ? WL_GU1 : WL_GU2)); d.ldb = D_; d.nN = 2 * F_ / 256; d.nt = D_ / 64;
            d.emode = E_GU; d.ss = SS + (size_t)(4 * layer + (first ? 0 : 2)) * SS_STRIDE * 2; d.o16 = (bf16_t*)(ws + OFF_R1);
            if (!first) { d.n2 = (M_ / 256) * (D_ / 256); d.daddr2 = LDS_DL + (36 + layer) * DESC_BYTES; }
        } else if (op == 1 || op == 9) {
            const bool first = (op == 1);
            d.A = (const bf16_t*)(ws + OFF_R1); d.lda = F_;
            d.Bt = (const bf16_t*)(wl + (first ? WL_D1 : WL_D2)); d.ldb = F_; d.nN = D_ / 256; d.nt = F_ / 64;
            d.emode = E_RESID; d.sub = 0; d.alpha = 0.5f;
            d.hsrc = (const float*)((first && layer > 0) ? HB1 : HB0); d.o16 = HB0;
            d.ssn = SS + (size_t)(4 * layer + (first ? 1 : 3)) * SS_STRIDE * 2;
        } else if (op == 2) {
            d.A = HB0; d.lda = D_; d.Bt = (const bf16_t*)(wl + WL_WIN); d.ldb = D_; d.nN = 2 * R_ / 256; d.nt = D_ / 64;
            d.emode = E_WIN; d.ss = SS + (size_t)(4 * layer + 1) * SS_STRIDE * 2; d.o16 = (bf16_t*)(ws + OFF_R1);
        } else if (op == 4) {
            d.A = (const bf16_t*)(ws + OFF_R4); d.lda = R_; d.Bt = (const bf16_t*)(wl + WL_WG); d.ldb = R_; d.nN = 2 * R_ / 256; d.nt = 0; d.kmode = 2;
            d.emode = E_GATES; d.v0 = PL->in[I_LBA] + (size_t)jl * R_; d.v1 = PL->in[I_LBX] + (size_t)jl * R_; d.v2 = PL->in[I_LAP] + (size_t)jl * R_;
            d.pp = (const bf16_t*)(ws + OFF_R4); d.o16 = (bf16_t*)(ws + OFF_R2); d.o16b = (bf16_t*)(ws + OFF_R2) + (size_t)M_ * R_;
        } else if (op == 7) {
            d.A = (const bf16_t*)(ws + OFF_R5); d.lda = R_; d.Bt = (const bf16_t*)(wl + WL_WOUT); d.ldb = R_; d.nN = D_ / 256; d.nt = R_ / 64;
            d.emode = E_RESID; d.sub = 0; d.alpha = 1.0f; d.hsrc = (const float*)HB0; d.o16 = HB0; d.ssn = SS + (size_t)(4 * layer + 2) * SS_STRIDE * 2;
        } else if (op == 13) {
            d.A = (const bf16_t*)(ws + OFF_R1); d.lda = D_; d.Bt = (const bf16_t*)(wl + WL_MIX); d.ldb = D_; d.nN = D_ / 256; d.nt = 4; d.kmode = 1;
            d.emode = E_RESID; d.sub = 1; d.v0 = PL->in[I_PB] + (size_t)jl * D_; d.v1 = PL->in[I_PS] + (size_t)jl * D_;
            d.hsrc = (const float*)HB0; d.o16 = HB0; d.ssn = SS + (size_t)(4 * layer + 2) * SS_STRIDE * 2;
        } else if (op == 10) {
            d.A = (const bf16_t*)(ws + OFF_PBALL) + layer * PLE_; d.lda = D_; d.Bt = (const bf16_t*)(ws + OFF_WPPALL) + layer * PLE_; d.ldb = D_; d.nN = D_ / 256; d.nt = PLE_ / 64;
            d.emode = E_PROJ; d.o16 = (bf16_t*)(ws + OFF_R4);
        } else if (op == 11) {
            d.A = HB0; d.lda = D_; d.Bt = (const bf16_t*)(wl + WL_PG); d.ldb = D_; d.nN = D_ / 256; d.nt = D_ / 64;
            d.emode = E_RESID; d.sub = 2; d.ss = SS + (size_t)(4 * layer + 3) * SS_STRIDE * 2; d.pp = (const bf16_t*)(ws + OFF_R4);
            d.hsrc = (const float*)HB0; d.o16 = HB1; d.ssn = SS + (size_t)(4 * layer + 4) * SS_STRIDE * 2;
        }
    }
}

__global__ void __launch_bounds__(NTHR, 2) fwd_megakernel(Params P) {
    extern __shared__ __attribute__((aligned(16))) unsigned char lds_raw[];
    LAS unsigned char* lds = (LAS unsigned char*)lds_raw;
    const int tid = threadIdx.x, G = gridDim.x;
    volatile LAS unsigned* st = (volatile LAS unsigned*)(lds + LDS_STAGE);
    LAS Params* PLw = (LAS Params*)(lds + LDS_PL);
    static_assert(sizeof(Params) <= 256 && sizeof(GemmDesc) == DESC_BYTES, "lds ctl");
    if (tid == 0) {
        st[0] = 0u; st[1] = 0u; st[2] = 0u; st[3] = 0u;
#pragma unroll
        for (int i = 0; i < 27; ++i) PLw->in[i] = P.in[i];
        PLw->out = P.out; PLw->ws = P.ws; PLw->lo = P.lo; PLw->hi = P.hi;
        build_table((PLp)PLw, (LAS GemmDesc*)(lds + LDS_DL));
    }
    __syncthreads();
    PLp PL = (PLp)PLw;
    const int lo = P.lo, hi = P.hi;
#if ONE_LAUNCH
    xcd_barrier_post((unsigned*)(P.ws + OFF_CTL), st);
    __syncthreads();
#endif

    unsigned long long tacc = 0, t0 = 0;
#define T_BEGIN() do { if (TMASK) t0 = __builtin_amdgcn_s_memrealtime(); } while (0)
#define T_END(bit) do { if ((TMASK >> (bit)) & 1) tacc += __builtin_amdgcn_s_memrealtime() - t0; } while (0)
    for (int step = lo; step < hi; ++step) {
        if (step == -1) {
            T_BEGIN();
            init_phase(PL, G);
            prep_global(PL, lds, G);
            prep_layer(PL, 0, OFF_WL0, lds, (int)blockIdx.x, G, 2);
            T_END(14);
#if ONE_LAUNCH
            cg::this_grid().sync();
#endif
            continue;
        }
        if (step == 36) { T_BEGIN(); final_phase(PL, G); T_END(15);
            if (TMASK && blockIdx.x == TBLK) { asm volatile("s_waitcnt vmcnt(0)" ::: "memory"); const unsigned long long ts = __builtin_amdgcn_s_memrealtime(); while (__builtin_amdgcn_s_memrealtime() - ts < tacc * TMULT) __builtin_amdgcn_s_sleep(8); }
            continue; }
        const int daddr = LDS_DL + step * DESC_BYTES;
        DescP dd = opaque_desc(daddr);
        const int op = rfl(dd->op), layer = rfl(dd->layer);
        T_BEGIN();
        if (op == 3) conv_phase(PL, layer >> 1, G);
        else if (op == 5) scan1_phase(PL, G);
        else if (op == 6) scan2_phase(PL, G);
        else if (op == 12) pool_prep_phase(PL, layer, lds, G);
        else {
            { unsigned long long tk = 0; gemm_phase(lds, daddr, G, (int)blockIdx.x, tk); if (((TMASK >> 18) & 1) && ((TMASK >> op) & 1)) tacc += ((TMASK >> 19) & 1) ? tk / 20 : tk; }
            if (TMASK) { if (((TMASK >> op) & 1) && !((TMASK >> 18) & 1)) tacc += __builtin_amdgcn_s_memrealtime() - t0; T_BEGIN(); }
            if ((op == 0 || op == 8) && layer < 3) {
                const int tot = (M_ / 256) * (2 * F_ / 256), rem = tot % G;
                if ((int)blockIdx.x >= rem) prep_layer(PL, layer + 1, ((layer + 1) & 1) ? OFF_WL1 : OFF_WL0, lds, (int)blockIdx.x - rem, G - rem, op == 8 ? 1 : 0);
                T_END(17); T_BEGIN();
            }
        }
        if (TMASK) { if (op == 3 || op == 5 || op == 6 || op == 12) { if ((TMASK >> op) & 1) tacc += __builtin_amdgcn_s_memrealtime() - t0; } T_BEGIN(); }
#if ONE_LAUNCH
        xcd_barrier(st);
#endif
        T_END(16);
    }
}

extern "C" void kernel_launch(void* const* d_in, const int* in_sizes, int n_in, void* d_out, int out_size, void* d_ws, size_t ws_size, hipStream_t stream) {
    static int grid = 0;
    if (grid == 0) {
        if (n_in != 27 || out_size != M_ * D_ || ws_size < WS_END) { fprintf(stderr, "kernel_launch: bad shapes n_in %d out %d ws %zu (need %zu)\n", n_in, out_size, ws_size, (size_t)WS_END); grid = -1; return; }
        int dev = 0, cus = 0, per_cu = 0;
        hipGetDevice(&dev); hipDeviceGetAttribute(&cus, hipDeviceAttributeMultiprocessorCount, dev);
        if (hipFuncSetAttribute((const void*)fwd_megakernel, hipFuncAttributeMaxDynamicSharedMemorySize, LDS_BYTES) != hipSuccess) { fprintf(stderr, "kernel_launch: hipFuncSetAttribute failed\n"); grid = -1; return; }
        hipOccupancyMaxActiveBlocksPerMultiprocessor(&per_cu, (const void*)fwd_megakernel, NTHR, LDS_BYTES);
        (void)hipGetLastError();
        if (per_cu < 1) fprintf(stderr, "kernel_launch: occupancy query reports %d blocks per CU\n", per_cu);
        grid = cus;
    }
    if (grid < 0) return;
    hipMemsetAsync((char*)d_ws + OFF_CTL, 0, 16384, stream);
    Params p{};
    for (int i = 0; i < 27; ++i) p.in[i] = (const float*)d_in[i];
    p.out = (float*)d_out; p.ws = (unsigned char*)d_ws;
#if ONE_LAUNCH
    p.lo = -1; p.hi = 37;
    void* args[] = {&p};
    hipError_t e = hipLaunchCooperativeKernel((const void*)fwd_megakernel, dim3(grid), dim3(NTHR), args, LDS_BYTES, stream);
    if (e != hipSuccess) fprintf(stderr, "cooperative launch failed: %s (grid %d)\n", hipGetErrorString(e), grid);
#else
    for (int s = -1; s < 37; ++s) { p.lo = s; p.hi = s + 1; hipLaunchKernelGGL(fwd_megakernel, dim3(grid), dim3(NTHR), LDS_BYTES, stream, p); }
#endif
}
```

```cpp
#include <hip/hip_runtime.h>
#include <hip/hip_cooperative_groups.h>
#include <cstdio>
namespace cg = cooperative_groups;

#ifndef ONE_LAUNCH
#define ONE_LAUNCH 1
#endif

#ifndef TMASK
#define TMASK 0
#endif
#define TMULT 4
#ifndef TBLK
#define TBLK 0
#endif
#define LAS __attribute__((address_space(3)))
typedef unsigned short bf16_t;
typedef short bf16x8 __attribute__((ext_vector_type(8)));
typedef float f32x4 __attribute__((ext_vector_type(4)));
typedef float f32x2 __attribute__((ext_vector_type(2)));
typedef unsigned u32x4 __attribute__((ext_vector_type(4)));
typedef unsigned u32x2 __attribute__((ext_vector_type(2)));

constexpr int M_ = 16384, D_ = 1024, F_ = 2816, R_ = 1280, S_ = 8192, PLE_ = 256;
constexpr float EPS_ = 1e-6f;
constexpr int NTHR = 512, NWAVES = 8;

constexpr size_t OFF_CTL = 0;
constexpr size_t OFF_SS  = 16384;
constexpr size_t SS_STRIDE = (size_t)M_;
constexpr size_t OFF_AGG = OFF_SS + 17 * SS_STRIDE * 8;
constexpr float SS_FX = 16777216.0f, SS_IFX = 1.0f / 16777216.0f;
constexpr size_t AGG_ELEMS = (size_t)2 * 128 * R_;
constexpr size_t OFF_WL0 = OFF_AGG + 2 * AGG_ELEMS * 4;
constexpr size_t WL_GU1 = 0;
constexpr size_t WL_D1  = WL_GU1 + (size_t)2 * F_ * D_ * 2;
constexpr size_t WL_GU2 = WL_D1 + (size_t)D_ * F_ * 2;
constexpr size_t WL_D2  = WL_GU2 + (size_t)2 * F_ * D_ * 2;
constexpr size_t WL_MIX = WL_D2 + (size_t)D_ * F_ * 2;
constexpr size_t WL_WIN = WL_MIX;
constexpr size_t WL_WG  = WL_WIN + (size_t)2 * R_ * D_ * 2;
constexpr size_t WL_WOUT = WL_WG + (size_t)2 * R_ * R_ * 2;
constexpr size_t WL_PG  = WL_WOUT + (size_t)D_ * R_ * 2;
constexpr size_t WL_SIZE = WL_PG + (size_t)D_ * D_ * 2;
constexpr size_t OFF_WL1 = OFF_WL0 + WL_SIZE;
constexpr size_t OFF_HB0 = OFF_WL1 + WL_SIZE;
constexpr size_t OFF_R1  = OFF_HB0 + (size_t)M_ * D_ * 2;
constexpr size_t OFF_R2  = OFF_R1 + (size_t)M_ * F_ * 2;
constexpr size_t OFF_R4  = OFF_R2 + (size_t)M_ * R_ * 4;
constexpr size_t OFF_R5  = OFF_R4 + (size_t)M_ * R_ * 2;
constexpr size_t OFF_PBALL = OFF_R5 + (size_t)M_ * R_ * 2;
constexpr size_t OFF_WPPALL = OFF_PBALL + (size_t)M_ * D_ * 2;
constexpr size_t WS_END  = OFF_WPPALL + (size_t)D_ * D_ * 2;
static_assert(OFF_WL0 % 256 == 0 && WL_SIZE % 256 == 0, "align");

constexpr int LDS_STAGE = 131072;
constexpr int LDS_PL = LDS_STAGE + 64, LDS_DL = LDS_PL + 256, DESC_BYTES = 152, LDS_RSC = LDS_DL + 40 * DESC_BYTES, LDS_BYTES = LDS_RSC + 8 * 512 * 4;

struct Params {
    const float* in[27];
    float* out;
    unsigned char* ws;
    int lo, hi;
};
enum { I_X = 0, I_P, I_F1N, I_F1G, I_F1U, I_F1D, I_MIXN, I_LWIN, I_LCW, I_LCB, I_LWA, I_LBA, I_LWX, I_LBX, I_LAP, I_LWOUT,
       I_PW, I_PB, I_PS, I_F2N, I_F2G, I_F2U, I_F2D, I_PLN, I_PLG, I_PLP, I_FN };

__device__ __forceinline__ unsigned pk2(float lo, float hi) { unsigned r; asm volatile("v_cvt_pk_bf16_f32 %0, %1, %2" : "=v"(r) : "v"(lo), "v"(hi)); return r; }
__device__ __forceinline__ float bf_lo(unsigned w) { return __uint_as_float(w << 16); }
__device__ __forceinline__ float bf_hi(unsigned w) { return __uint_as_float(w & 0xffff0000u); }
__device__ __forceinline__ float fsigmoid(float x) { return __builtin_amdgcn_rcpf(1.0f + __expf(-x)); }
__device__ __forceinline__ float wave_sum(float v) {
#pragma unroll
    for (int o = 1; o < 64; o <<= 1) v += __shfl_xor(v, o);
    return v;
}
__device__ __forceinline__ int opaque_tid() { int t = threadIdx.x; asm volatile("" : "+v"(t)); return t; }
__device__ __forceinline__ int opaque_bid() { int b = blockIdx.x; asm volatile("" : "+s"(b)); return b; }
__device__ __forceinline__ int opaque_s(int v) { v = __builtin_amdgcn_readfirstlane(v); asm volatile("" : "+s"(v)); return v; }
__device__ __forceinline__ void st_wt8(void* p, u32x2 v) { *(u32x2*)p = v; }
__device__ __forceinline__ void st_wt16f(float* p, f32x4 v) { *(f32x4*)p = v; }
__device__ __forceinline__ f32x4 zero4() { float z = 0.f; asm volatile("" : "+v"(z)); return (f32x4){z, z, z, z}; }
typedef unsigned long long u64;
__device__ __forceinline__ float ss_get(const float* p, int row) { return (float)(((const u64*)p)[row]) * SS_IFX; }
#define LDS_WAIT() asm volatile("s_waitcnt lgkmcnt(0)" ::: "memory")

#define XB_TMO      128
#define XB_XCNT(j)  (256  + 64 * (j))
#define XB_XSUB(j)  (1280 + 64 * (j))
#define XB_XGEN(j)  (2304 + 64 * (j))
#define XB_TOP      3328
#define XB_TOPGEN   3392
#define XCD_BAR_WORDS 3456
#define XB_SPIN_CAP (1u << 22)
__device__ __forceinline__ unsigned xb_ld(unsigned* p)              { return __hip_atomic_load(p, __ATOMIC_RELAXED, __HIP_MEMORY_SCOPE_AGENT); }
__device__ __forceinline__ unsigned xb_add(unsigned* p, unsigned v) { return __hip_atomic_fetch_add(p, v, __ATOMIC_RELAXED, __HIP_MEMORY_SCOPE_AGENT); }
__device__ __forceinline__ unsigned xb_xcc_id() { return (unsigned)__builtin_amdgcn_s_getreg((3 << 11) | 20) & 0xFu; }
#define XB_SPIN(cond, bar) do { unsigned _sp = 0; while (cond) { __builtin_amdgcn_s_sleep(1); \
    if ((++_sp & 255u) == 0u) { if (xb_ld(&(bar)[XB_TMO])) break; if (_sp > XB_SPIN_CAP) { atomicAdd(&(bar)[XB_TMO], 1u); break; } } } } while (0)
__device__ __forceinline__ void xcd_barrier_post(unsigned* bar, volatile LAS unsigned* st) {
    if (threadIdx.x == 0) { const unsigned x = xb_xcc_id(); st[2] = x; *(volatile LAS unsigned long long*)(st + 4) = (unsigned long long)bar; (void)xb_add(&bar[XB_XCNT(x)], 1u); }
}
__device__ __forceinline__ void xcd_barrier_complete(unsigned* bar, unsigned x, unsigned& nloc, unsigned& nx) {
    const unsigned G = gridDim.x * gridDim.y * gridDim.z;
    unsigned sum, cnt, mine, sp = 0u;
    for (;;) {
        sum = 0u; cnt = 0u;
        for (unsigned j = 0; j < 16; ++j) { const unsigned c = xb_ld(&bar[XB_XCNT(j)]); sum += c; cnt += (c > 0u) ? 1u : 0u; }
        mine = xb_ld(&bar[XB_XCNT(x)]);
        if (sum == G) break;
        __builtin_amdgcn_s_sleep(1);
        if ((++sp & 255u) == 0u) { if (xb_ld(&bar[XB_TMO])) break; if (sp > XB_SPIN_CAP) { atomicAdd(&bar[XB_TMO], 1u); break; } }
    }
    nloc = mine > 0u ? mine : 1u; nx = cnt > 0u ? cnt : 1u;
}
__device__ __forceinline__ void xcd_barrier(volatile LAS unsigned* st) {
    asm volatile("s_waitcnt vmcnt(0)" ::: "memory");
    __syncthreads();
    if (opaque_tid() == 0) {
        unsigned* bar = (unsigned*)(*(volatile LAS unsigned long long*)(st + 4));
        const unsigned x = st[2];
        __builtin_amdgcn_s_waitcnt(0);
        unsigned nloc = st[0], nx = st[1];
        if (nloc == 0u) { xcd_barrier_complete(bar, x, nloc, nx); st[0] = nloc; st[1] = nx; }
        const unsigned g = st[3]; st[3] = g + 1u;
        const unsigned old = xb_add(&bar[XB_XSUB(x)], 1u);
        if (old + 1u == (g + 1u) * nloc) {
            __builtin_amdgcn_fence(__ATOMIC_RELEASE, "agent");
            asm volatile("s_waitcnt vmcnt(0)" ::: "memory");
            const unsigned og = xb_add(&bar[XB_TOP], 1u);
            if (og + 1u == (g + 1u) * nx) (void)__hip_atomic_fetch_add(&bar[XB_TOPGEN], 1u, __ATOMIC_RELAXED, __HIP_MEMORY_SCOPE_AGENT);
        }
        XB_SPIN(xb_ld(&bar[XB_TOPGEN]) <= g, bar);
        __builtin_amdgcn_fence(__ATOMIC_ACQUIRE, "agent");
        asm volatile("s_waitcnt vmcnt(0)" ::: "memory");
    }
    __syncthreads();
}

constexpr int BM = 256, BK = 64, HALF = 128, HTB = HALF * BK * 2, NXCD = 8, WGM = 8;
__device__ __forceinline__ int lds_byte(int r, int c) { const int st = (r >> 4) * 2 + (c >> 5), rr = r & 15, cc = c & 31, ob = rr * 64 + cc * 2; return st * 1024 + (ob ^ (((ob >> 9) & 1) << 5)); }
__device__ __forceinline__ void stage_rc(int b, int& R, int& C) { const int st = b / 1024, sb = b % 1024, swz = sb ^ (((sb >> 9) & 1) << 5); R = (st >> 1) * 16 + swz / 64; C = (st & 1) * 32 + (swz % 64) / 2; }

enum { E_GU = 0, E_RESID = 1, E_WIN = 2, E_GATES = 3, E_PROJ = 4 };
struct GemmDesc {
    const bf16_t* A; const bf16_t* Bt;
    int lda, ldb, nM, nN, nt, kmode;
    int emode, sub;
    float alpha;
    const float* ss;
    bf16_t* o16;
    float* o32;
    const float* hsrc;
    float* ssn;
    const float* v0; const float* v1; const float* v2;
    const bf16_t* pp;
    bf16_t* o16b;
    int op, layer;
    int n2, daddr2;
};
struct Unit { int pm, pn, nt, daddr; const char* cA; const char* cB; };

__device__ __forceinline__ int rfl(int v) { return __builtin_amdgcn_readfirstlane(v); }
__device__ __forceinline__ const char* rfl_ptr(const char* p) { const unsigned long long u = (unsigned long long)p; const unsigned lo = (unsigned)__builtin_amdgcn_readfirstlane((int)(unsigned)u), hi = (unsigned)__builtin_amdgcn_readfirstlane((int)(unsigned)(u >> 32)); return (const char*)(((unsigned long long)hi << 32) | lo); }
typedef const LAS GemmDesc* DescP;
__device__ __forceinline__ DescP opaque_desc(int daddr) { unsigned a = (unsigned)daddr; asm volatile("" : "+v"(a)); return (DescP)a; }
__device__ __forceinline__ bool unit_next(int daddr, int i, int G, int c, Unit& u) {
    DescP d = opaque_desc(daddr);
    int nM = rfl(d->nM), nN = rfl(d->nN), nwg = nM * nN;
    const int n2 = rfl(d->n2);
    long L = (long)i * G + c; if (L >= nwg + n2) return false;
    u.daddr = daddr;
    if (L >= nwg) { L -= nwg; u.daddr = rfl(d->daddr2); d = opaque_desc(u.daddr); nM = rfl(d->nM); nN = rfl(d->nN); nwg = nM * nN; }
    int wgid = (int)L; { const int q = nwg / NXCD, r = nwg % NXCD, xcd = wgid % NXCD, off = wgid / NXCD; wgid = (xcd < r ? xcd * (q + 1) : r * (q + 1) + (xcd - r) * q) + off; }
    const int nig = WGM * nN, gid = wgid / nig, fm = gid * WGM, gsz = (nM - fm) < WGM ? (nM - fm) : WGM;
    u.pm = fm + ((wgid % nig) % gsz); u.pn = (wgid % nig) / gsz;
    const int kmode = rfl(d->kmode), lda = rfl(d->lda), ldb = rfl(d->ldb);
    int koffA = 0, koffB = 0, nt = rfl(d->nt);
    if (kmode == 1) { koffA = u.pn * 256; }
    else if (kmode == 2) {
        const int c0 = u.pn * 128, h0 = c0 / 80, h1 = (c0 + 127) / 80;
        int k0 = (h0 * 80) & ~63; int k1 = ((h1 + 1) * 80 + 63) & ~63; if (k1 > R_) k1 = R_;
        nt = (k1 - k0) / 64; if (nt & 1) { ++nt; if (k0 + nt * 64 > R_) k0 = R_ - nt * 64; }
        koffA = k0; koffB = k0;
    }
    u.nt = nt;
    u.cA = rfl_ptr((const char*)d->A + ((size_t)u.pm * 256 * lda + koffA) * 2);
    u.cB = rfl_ptr((const char*)d->Bt + ((size_t)u.pn * 256 * ldb + koffB) * 2);
    return true;
}

__device__ __forceinline__ float gelu_tanh(float x) { const float t = x + 0.044715f * x * x * x; return x * __builtin_amdgcn_rcpf(1.0f + __expf(-1.5957691216f * t)); }

__device__ __forceinline__ void epilogue(int daddr, f32x4 (&acc)[2][2][4][2], int pm, int pn, int wr, int wc, int fr, int fq, int& rs_tag) {
    DescP dl = opaque_desc(daddr);
    int tid_e;
    { const int t_ = opaque_tid(); tid_e = t_; const int w_ = __builtin_amdgcn_readfirstlane(t_ >> 6), l_ = t_ & 63; wr = w_ >> 2; wc = w_ & 3; fr = l_ & 15; fq = l_ >> 4; }
    const int emode = rfl(dl->emode);
    const int row0 = pm * BM + wr * 64 + fr;
    const int cw = wc * 32 + fq * 4;
    float rsv[8];
    {
        const float* ssp = dl->ss;
        LAS float* rsc = (LAS float*)(unsigned)(LDS_RSC) + tid_e;
        if (ssp) {
            if (rs_tag != pm) {
#pragma unroll
                for (int i = 0; i < 8; ++i) rsv[i] = ss_get(ssp, row0 + (i >> 2) * HALF + (i & 3) * 16);
#pragma unroll
                for (int i = 0; i < 8; ++i) { rsv[i] = rsqrtf(rsv[i] * (1.0f / D_) + EPS_); rsc[i * 512] = rsv[i]; }
                rs_tag = pm;
            } else {
#pragma unroll
                for (int i = 0; i < 8; ++i) rsv[i] = rsc[i * 512];
            }
        } else {
#pragma unroll
            for (int i = 0; i < 8; ++i) rsv[i] = 1.0f;
        }
    }
    if (emode == E_GU) {
        bf16_t* const o16 = dl->o16;
#pragma unroll
        for (int ai = 0; ai < 2; ++ai)
#pragma unroll
            for (int m = 0; m < 4; ++m) {
                const int row = row0 + ai * HALF + m * 16;
                const float rs = rsv[ai * 4 + m];
                bf16_t* op = o16 + (size_t)row * F_ + pn * 128 + wc * 32 + fq * 8;
                u32x4 w4;
#pragma unroll
                for (int n = 0; n < 2; ++n) {
                    const f32x4 g = acc[ai][0][m][n] * rs, u = acc[ai][1][m][n] * rs;
                    float o[4];
#pragma unroll
                    for (int j = 0; j < 4; ++j) o[j] = g[j] * fsigmoid(g[j]) * u[j];
                    if (n == 0) { w4.x = pk2(o[0], o[1]); w4.y = pk2(o[2], o[3]); } else { w4.z = pk2(o[0], o[1]); w4.w = pk2(o[2], o[3]); }
                }
                *(u32x4*)op = w4;
                asm volatile("" ::: "memory");
            }
    } else if (emode == E_RESID) {
        const int sub = rfl(dl->sub); const float alpha = dl->alpha;
        const bf16_t* const h16 = (const bf16_t*)dl->hsrc; bf16_t* const o16 = dl->o16; float* const ssn = dl->ssn; const bf16_t* const pp = dl->pp;
        const int cwp = wc * 32 + fq * 8;
#pragma unroll
        for (int ai = 0; ai < 2; ++ai) {
            u32x4 hv[4][2];
#pragma unroll
            for (int mm = 0; mm < 4; ++mm) {
                const size_t off = (size_t)(row0 + ai * HALF + mm * 16) * D_ + pn * 256 + cwp;
#pragma unroll
                for (int bj = 0; bj < 2; ++bj) hv[mm][bj] = *(const u32x4*)(h16 + off + bj * HALF);
            }
#pragma unroll
            for (int m = 0; m < 4; ++m) {
                const int row = row0 + ai * HALF + m * 16;
                const size_t off = (size_t)row * D_ + pn * 256 + cwp;
                const float rs = rsv[ai * 4 + m];
                float q = 0.f;
#pragma unroll
                for (int bj = 0; bj < 2; ++bj) {
                    const size_t o2 = off + bj * HALF;
                    u32x4 p4 = (u32x4){0u, 0u, 0u, 0u};
                    if (sub == 2) p4 = *(const u32x4*)(pp + o2);
                    const u32x4 h4 = hv[m][bj];
                    u32x4 w4;
#pragma unroll
                    for (int n = 0; n < 2; ++n) {
                        f32x4 v = acc[ai][bj][m][n];
                        if (sub == 0) v = v * alpha;
                        else if (sub == 1) { const int col = pn * 256 + cwp + bj * HALF + 4 * n; v = (v + *(const f32x4*)(dl->v0 + col)) * *(const f32x4*)(dl->v1 + col); }
                        else { const unsigned pa = n ? p4.z : p4.x, pb = n ? p4.w : p4.y;
                            v[0] = fsigmoid(v[0] * rs) * bf_lo(pa); v[1] = fsigmoid(v[1] * rs) * bf_hi(pa);
                            v[2] = fsigmoid(v[2] * rs) * bf_lo(pb); v[3] = fsigmoid(v[3] * rs) * bf_hi(pb); }
                        const unsigned ha = n ? h4.z : h4.x, hb_ = n ? h4.w : h4.y;
                        const f32x4 hn = (f32x4){bf_lo(ha), bf_hi(ha), bf_lo(hb_), bf_hi(hb_)} + v;
                        if (n == 0) { w4.x = pk2(hn[0], hn[1]); w4.y = pk2(hn[2], hn[3]); } else { w4.z = pk2(hn[0], hn[1]); w4.w = pk2(hn[2], hn[3]); }
                        q += (hn[0] * hn[0] + hn[1] * hn[1]) + (hn[2] * hn[2] + hn[3] * hn[3]);
                    }
                    *(u32x4*)(o16 + o2) = w4;
                }
                q += __shfl_xor(q, 16); q += __shfl_xor(q, 32);
                if (fq == 0) atomicAdd((u64*)ssn + row, (u64)(q * SS_FX));
            }
            asm volatile("" ::: "memory");
        }
    } else if (emode == E_WIN) {
        bf16_t* const o16 = dl->o16;
        const bool isg = pn < 5;
        const int cwp = wc * 32 + fq * 8;
#pragma unroll
        for (int ai = 0; ai < 2; ++ai)
#pragma unroll
            for (int m = 0; m < 4; ++m) {
                const int row = row0 + ai * HALF + m * 16;
                const float rs = rsv[ai * 4 + m];
                const size_t off = (size_t)row * (2 * R_) + pn * 256 + cwp;
#pragma unroll
                for (int bj = 0; bj < 2; ++bj) {
                    u32x4 w4;
#pragma unroll
                    for (int n = 0; n < 2; ++n) {
                        f32x4 v = acc[ai][bj][m][n] * rs;
                        if (isg) { v[0] = gelu_tanh(v[0]); v[1] = gelu_tanh(v[1]); v[2] = gelu_tanh(v[2]); v[3] = gelu_tanh(v[3]); }
                        if (n == 0) { w4.x = pk2(v[0], v[1]); w4.y = pk2(v[2], v[3]); } else { w4.z = pk2(v[0], v[1]); w4.w = pk2(v[2], v[3]); }
                    }
                    *(u32x4*)(o16 + off + bj * HALF) = w4;
                }
                asm volatile("" ::: "memory");
            }
    } else if (emode == E_GATES) {
        const float* const v0 = dl->v0; const float* const v1 = dl->v1; const float* const v2 = dl->v2; const bf16_t* const pp = dl->pp; bf16_t* const o16 = dl->o16; bf16_t* const o16b = dl->o16b;
        const int c0 = pn * 128 + wc * 32 + fq * 8;
        u32x4 xw[8];
#pragma unroll
        for (int i = 0; i < 8; ++i) xw[i] = *(const u32x4*)(pp + (size_t)(row0 + (i >> 2) * HALF + (i & 3) * 16) * R_ + c0);
        f32x4 ba[2], bx[2], sp8[2];
#pragma unroll
        for (int n = 0; n < 2; ++n) {
            ba[n] = *(const f32x4*)(v0 + c0 + 4 * n); bx[n] = *(const f32x4*)(v1 + c0 + 4 * n);
            const f32x4 ap = *(const f32x4*)(v2 + c0 + 4 * n);
#pragma unroll
            for (int j = 0; j < 4; ++j) {
                const float z = -ap[j], e = __expf(-fabsf(z));
                const float l1p = (e < 0.03125f) ? e * (1.0f - e * (0.5f - e * (0.33333333f - 0.25f * e))) : __logf(1.0f + e);
                sp8[n][j] = 8.0f * (fmaxf(z, 0.f) + l1p);
            }
        }
#pragma unroll
        for (int ai = 0; ai < 2; ++ai)
#pragma unroll
            for (int m = 0; m < 4; ++m) {
                const int row = row0 + ai * HALF + m * 16;
                const size_t idx = (size_t)row * R_ + c0;
                const u32x4 x4 = xw[ai * 4 + m];
                u32x4 wl, wb;
#pragma unroll
                for (int n = 0; n < 2; ++n) {
                    const unsigned xa = n ? x4.z : x4.x, xb_ = n ? x4.w : x4.y;
                    const float xc[4] = {bf_lo(xa), bf_hi(xa), bf_lo(xb_), bf_hi(xb_)};
                    const f32x4 ar = acc[ai][0][m][n] + ba[n], ax = acc[ai][1][m][n] + bx[n];
                    float la[4], bv[4];
#pragma unroll
                    for (int j = 0; j < 4; ++j) {
                        const float r = fsigmoid(ar[j]), ig = fsigmoid(ax[j]);
                        la[j] = -sp8[n][j] * r;
                        const float y = 2.0f * la[j];
                        const float om = fmaxf(1.0f - __expf(y), 0.f);
                        bv[j] = sqrtf(om) * ig * xc[j];
                    }
                    if (n == 0) { wl.x = pk2(la[0], la[1]); wl.y = pk2(la[2], la[3]); wb.x = pk2(bv[0], bv[1]); wb.y = pk2(bv[2], bv[3]); }
                    else { wl.z = pk2(la[0], la[1]); wl.w = pk2(la[2], la[3]); wb.z = pk2(bv[0], bv[1]); wb.w = pk2(bv[2], bv[3]); }
                }
                *(u32x4*)(o16 + idx) = wl;
                *(u32x4*)(o16b + idx) = wb;
                asm volatile("" ::: "memory");
            }
    } else {
        bf16_t* const o16 = dl->o16;
        const int cwp = wc * 32 + fq * 8;
#pragma unroll
        for (int ai = 0; ai < 2; ++ai)
#pragma unroll
            for (int m = 0; m < 4; ++m) {
                const int row = row0 + ai * HALF + m * 16;
                const size_t off = (size_t)row * D_ + pn * 256 + cwp;
#pragma unroll
                for (int bj = 0; bj < 2; ++bj) {
                    const f32x4 v0_ = acc[ai][bj][m][0], v1_ = acc[ai][bj][m][1];
                    u32x4 w4; w4.x = pk2(v0_[0], v0_[1]); w4.y = pk2(v0_[2], v0_[3]); w4.z = pk2(v1_[0], v1_[1]); w4.w = pk2(v1_[2], v1_[3]);
                    *(u32x4*)(o16 + off + bj * HALF) = w4;
                }
                asm volatile("" ::: "memory");
            }
    }
}

__device__ __forceinline__ void gemm_phase(LAS unsigned char* lds, int daddr, int G, int cidx, unsigned long long& tk) {
    daddr = opaque_s(daddr); DescP d = opaque_desc(daddr);
    const int tid = opaque_tid(), wid = __builtin_amdgcn_readfirstlane(tid >> 6), lane = tid & 63, wr = wid >> 2, wc = wid & 3, fr = lane & 15, fq = lane >> 4;
    G = opaque_s(G); cidx = opaque_s(cidx);
    unsigned voffA[2];
#pragma unroll
    for (int i = 0; i < 2; ++i) { int R, C; stage_rc(tid * 16 + i * 8192, R, C);
        voffA[i] = (unsigned)(R * rfl(d->lda) + C) * 2u; }
#define voffB voffA
    const size_t kstep = (size_t)(BK * 2);
    const size_t hstepA = (size_t)HALF * rfl(d->lda) * 2;
#define hstepB hstepA
    const unsigned ldsw = (unsigned)wid * 1024u;
    const int aoff = lds_byte(wr * 64 + fr, fq * 8), boff = lds_byte(wc * 32 + fr, fq * 8);
#define PG8_SA(b, h) (((b) * 2 + (h)) * HTB)
#define PG8_SB(b, h) ((4 + (b) * 2 + (h)) * HTB)
#define PG8_STAGE(bufoff, gbase, voff) do { _Pragma("unroll") for (int _i = 0; _i < 2; ++_i) \
        __builtin_amdgcn_global_load_lds((const unsigned*)((const char*)(gbase) + (voff)[_i]), (LAS unsigned*)(lds + (bufoff) + ldsw + _i * 8192), 16, 0, 0); } while (0)
#define PG8_LDA(dst, b, h) do { _Pragma("unroll") for (int m = 0; m < 4; ++m) _Pragma("unroll") for (int k = 0; k < 2; ++k) dst[m][k] = *(const LAS bf16x8*)(lds + PG8_SA(b, h) + aoff + m * 2048 + k * 1024); } while (0)
#define PG8_LDB(dst, b, h) do { _Pragma("unroll") for (int n = 0; n < 2; ++n) _Pragma("unroll") for (int k = 0; k < 2; ++k) dst[n][k] = *(const LAS bf16x8*)(lds + PG8_SB(b, h) + boff + n * 2048 + k * 1024); } while (0)
#define PG8_MMA(ai, bj, At, Bt) do { __builtin_amdgcn_s_setprio(1); _Pragma("unroll") for (int m = 0; m < 4; ++m) _Pragma("unroll") for (int n = 0; n < 2; ++n) _Pragma("unroll") for (int k = 0; k < 2; ++k) \
        acc[ai][bj][m][n] = __builtin_amdgcn_mfma_f32_16x16x32_bf16(Bt[n][k], At[m][k], acc[ai][bj][m][n], 0, 0, 0); __builtin_amdgcn_s_setprio(0); } while (0)
#define PG8_WAIT_V(n) asm volatile("s_waitcnt vmcnt(" #n ")" ::: "memory")
#define PG8_WAIT_L(n) asm volatile("s_waitcnt lgkmcnt(" #n ")" ::: "memory")
#define PG8_BAR __builtin_amdgcn_s_barrier()
#define PG8_SCHED __builtin_amdgcn_sched_barrier(0)
    Unit cur, nxt; int ui = 0; int rs_tag = -1;
    if (!unit_next(daddr, 0, G, cidx, cur)) return;
    f32x4 acc[2][2][4][2];
#pragma unroll
    for (int a = 0; a < 2; ++a)
#pragma unroll
        for (int b = 0; b < 2; ++b)
#pragma unroll
            for (int m = 0; m < 4; ++m)
#pragma unroll
                for (int n = 0; n < 2; ++n) acc[a][b][m][n] = (f32x4){0.f, 0.f, 0.f, 0.f};
    bf16x8 At[4][2], B0[2][2], B1[2][2];
    const char* cA = cur.cA; const char* cB = cur.cB;
    PG8_STAGE(PG8_SB(0, 0), cB, voffB); PG8_STAGE(PG8_SA(0, 0), cA, voffA); PG8_STAGE(PG8_SB(0, 1), cB + hstepB, voffB); PG8_STAGE(PG8_SA(0, 1), cA + hstepA, voffA);
    if (wr == 1) PG8_BAR;
    PG8_WAIT_V(4); PG8_BAR;
    PG8_STAGE(PG8_SB(1, 0), cB + kstep, voffB); PG8_STAGE(PG8_SA(1, 0), cA + kstep, voffA); PG8_STAGE(PG8_SB(1, 1), cB + hstepB + kstep, voffB);
    PG8_WAIT_V(6); PG8_BAR;
    for (;;) {
        const bool has_next = unit_next(daddr, ui + 1, G, cidx, nxt);
        const char* nA = has_next ? nxt.cA : cA; const char* nB = has_next ? nxt.cB : cB;
        const int nt = cur.nt;
        unsigned long long tk0 = 0; if ((TMASK >> 18) & 1) tk0 = ((TMASK >> 19) & 1) ? __builtin_amdgcn_s_memtime() : __builtin_amdgcn_s_memrealtime();
        for (int t = 0; t < nt; t += 2) {
            const bool last = (t == nt - 2);
            const char* a1 = cA + (size_t)(t + 1) * kstep;
            const char* a2 = last ? nA : cA + (size_t)(t + 2) * kstep; const char* b2 = last ? nB : cB + (size_t)(t + 2) * kstep;
            const char* a3 = a2 + kstep; const char* b3 = b2 + kstep;
            PG8_LDB(B0, 0, 0); PG8_SCHED; PG8_LDA(At, 0, 0); PG8_STAGE(PG8_SA(1, 1), a1 + hstepA, voffA);
            PG8_WAIT_L(8); PG8_BAR; PG8_WAIT_L(0); PG8_MMA(0, 0, At, B0); PG8_BAR; PG8_SCHED;
            PG8_LDB(B1, 0, 1); PG8_STAGE(PG8_SB(0, 0), b2, voffB);
            PG8_BAR; PG8_WAIT_L(0); PG8_MMA(0, 1, At, B1); PG8_BAR;
            PG8_LDA(At, 0, 1); PG8_STAGE(PG8_SA(0, 0), a2, voffA);
            PG8_BAR; PG8_WAIT_L(0); PG8_MMA(1, 0, At, B0); PG8_BAR; PG8_SCHED;
            PG8_STAGE(PG8_SB(0, 1), b2 + hstepB, voffB);
            PG8_WAIT_V(6); PG8_BAR; PG8_MMA(1, 1, At, B1); PG8_BAR;
            PG8_LDB(B0, 1, 0); PG8_SCHED; PG8_LDA(At, 1, 0); PG8_STAGE(PG8_SA(0, 1), a2 + hstepA, voffA);
            PG8_WAIT_L(8); PG8_BAR; PG8_WAIT_L(0); PG8_MMA(0, 0, At, B0); PG8_BAR; PG8_SCHED;
            PG8_LDB(B1, 1, 1); PG8_STAGE(PG8_SB(1, 0), b3, voffB);
            PG8_BAR; PG8_WAIT_L(0); PG8_MMA(0, 1, At, B1); PG8_BAR;
            PG8_LDA(At, 1, 1); PG8_STAGE(PG8_SA(1, 0), a3, voffA);
            PG8_BAR; PG8_WAIT_L(0); PG8_MMA(1, 0, At, B0); PG8_BAR; PG8_SCHED;
            PG8_STAGE(PG8_SB(1, 1), b3 + hstepB, voffB);
            PG8_WAIT_V(6); PG8_BAR; PG8_MMA(1, 1, At, B1); PG8_BAR;
        }
        if ((TMASK >> 18) & 1) tk += (((TMASK >> 19) & 1) ? __builtin_amdgcn_s_memtime() : __builtin_amdgcn_s_memrealtime()) - tk0;
        epilogue(cur.daddr, acc, cur.pm, cur.pn, wr, wc, fr, fq, rs_tag);
        if (!has_next) break;
#pragma unroll
        for (int a = 0; a < 2; ++a)
#pragma unroll
            for (int b = 0; b < 2; ++b)
#pragma unroll
                for (int m = 0; m < 4; ++m)
#pragma unroll
                    for (int n = 0; n < 2; ++n) acc[a][b][m][n] = (f32x4){0.f, 0.f, 0.f, 0.f};
        cur = nxt; cA = nA; cB = nB; ++ui;
    }
    PG8_WAIT_V(0);
    if (wr == 0) PG8_BAR;
    PG8_BAR;
#undef voffB
#undef hstepB
#undef PG8_SA
#undef PG8_SB
#undef PG8_STAGE
#undef PG8_LDA
#undef PG8_LDB
#undef PG8_MMA
#undef PG8_WAIT_V
#undef PG8_WAIT_L
#undef PG8_BAR
#undef PG8_SCHED
}

typedef const LAS Params* PLp;
__device__ __forceinline__ PLp opaque_pl() { unsigned a = LDS_PL; asm volatile("" : "+v"(a)); return (PLp)a; }
__device__ __forceinline__ void tr_item(const float* W, int K, int N, bf16_t* WT, int ldt, int gumode, int guoff, const float* scale, int item, int lane) {
    const int nkb = K / 16, nb = item / nkb, kb = item - nb * nkb, k0 = 16 * kb, n0 = 256 * nb;
    const float* src = W + (size_t)k0 * N + n0 + 4 * lane;
    f32x4 v[16];
#pragma unroll
    for (int i = 0; i < 16; ++i) v[i] = __builtin_nontemporal_load((const f32x4*)(src + (size_t)i * N));
    if (scale) {
#pragma unroll
        for (int i = 0; i < 16; ++i) v[i] = v[i] * scale[k0 + i];
    }
#pragma unroll
    for (int e = 0; e < 4; ++e) {
        const int n = n0 + 4 * lane + e;
        const int w5 = n & 31, rho = 16 * ((w5 >> 2) & 1) + 4 * (w5 >> 3) + (w5 & 3);
        const int row = gumode ? ((n >> 7) * 256 + guoff + ((n & 127) & ~31) + rho) : ((n & ~31) + rho);
        u32x4 o0, o1;
        o0.x = pk2(v[0][e], v[1][e]); o0.y = pk2(v[2][e], v[3][e]); o0.z = pk2(v[4][e], v[5][e]); o0.w = pk2(v[6][e], v[7][e]);
        o1.x = pk2(v[8][e], v[9][e]); o1.y = pk2(v[10][e], v[11][e]); o1.z = pk2(v[12][e], v[13][e]); o1.w = pk2(v[14][e], v[15][e]);
        bf16_t* dst = WT + (size_t)row * ldt + k0;
        *(u32x4*)dst = o0; *(u32x4*)(dst + 8) = o1;
    }
}

__device__ __forceinline__ void prep_layer(PLp P, int layer, size_t wloff, LAS unsigned char* lds, int widx, int nworkers, int part) {
    P = opaque_pl(); unsigned char* wl = P->ws + wloff;
    const int tid = opaque_tid(), lane = tid & 63, wave = __builtin_amdgcn_readfirstlane(tid >> 6); widx = opaque_s(widx); nworkers = opaque_s(nworkers);
    LAS float* scr = (LAS float*)(lds + wave * 8448);
    const int gw = widx * NWAVES + wave, NGW = nworkers * NWAVES;
    const int jl = layer >> 1; const bool lru = (layer & 1) == 0;
    constexpr int I_GU = (D_ / 16) * (F_ / 256), I_DN = (F_ / 16) * (D_ / 256), I_PGt = (D_ / 16) * (D_ / 256);
    constexpr int I_WIN = (D_ / 16) * (2 * R_ / 256), I_WOUT = (R_ / 16) * (D_ / 256), I_POOL = 4 * (256 / 16);
    const int nmix = lru ? (I_WIN + I_WOUT) : I_POOL;
    const int NITEMS = 6 * I_GU + I_PGt + nmix;
    static_assert(I_GU == I_DN, "items");
    const int H = lru ? (NITEMS * 9) / 16 : NITEMS / 2;
    const int it0 = (part == 1) ? H : 0, it1 = (part == 0) ? H : NITEMS;
    const size_t WFF = (size_t)D_ * F_;
    for (int it = it0 + gw; it < it1; it += NGW) {
        int r = it;
        const float* W; int K, N; bf16_t* WT; int gumode = 0, guoff = 0, ldt = 0; const float* scale = nullptr;
        if (r < 3 * I_GU) {
            const int which = r / I_GU; r -= which * I_GU;
            if (which < 2) { W = P->in[which ? I_F1U : I_F1G] + layer * WFF; K = D_; N = F_; WT = (bf16_t*)(wl + WL_GU1); gumode = 1; guoff = which * 128; scale = P->in[I_F1N] + layer * D_; }
            else { W = P->in[I_F1D] + layer * WFF; K = F_; N = D_; WT = (bf16_t*)(wl + WL_D1); }
        } else if (r < 6 * I_GU) {
            r -= 3 * I_GU; const int which = r / I_GU; r -= which * I_GU;
            if (which < 2) { W = P->in[which ? I_F2U : I_F2G] + layer * WFF; K = D_; N = F_; WT = (bf16_t*)(wl + WL_GU2); gumode = 1; guoff = which * 128; scale = P->in[I_F2N] + layer * D_; }
            else { W = P->in[I_F2D] + layer * WFF; K = F_; N = D_; WT = (bf16_t*)(wl + WL_D2); }
        } else {
            r -= 6 * I_GU;
            if (r < I_PGt) { W = P->in[I_PLG] + (size_t)layer * D_ * D_; K = D_; N = D_; WT = (bf16_t*)(wl + WL_PG); scale = P->in[I_PLN] + layer * D_; }
            else {
                r -= I_PGt;
                if (lru) {
                    if (r < I_WIN) { W = P->in[I_LWIN] + (size_t)jl * D_ * 2 * R_; K = D_; N = 2 * R_; WT = (bf16_t*)(wl + WL_WIN); scale = P->in[I_MIXN] + layer * D_; }
                    else { r -= I_WIN; W = P->in[I_LWOUT] + (size_t)jl * R_ * D_; K = R_; N = D_; WT = (bf16_t*)(wl + WL_WOUT); }
                } else {
                    const int g = r / 16; r = r % 16;
                    W = P->in[I_PW] + ((size_t)jl * 4 + g) * 256 * 256; K = 256; N = 256; ldt = D_; WT = (bf16_t*)(wl + WL_MIX) + (size_t)g * 256 * D_; scale = P->in[I_MIXN] + layer * D_ + g * 256;
                }
            }
        }
        K = opaque_s(rfl(K)); N = opaque_s(rfl(N));
        tr_item(W, K, N, WT, ldt ? ldt : K, gumode, guoff, scale, r, lane);
    }
    if (lru && part != 0) {
        const int gt = widx * NTHR + tid, NGT = nworkers * NTHR;
        const float* wa = P->in[I_LWA] + (size_t)jl * 16 * 80 * 80; const float* wx = P->in[I_LWX] + (size_t)jl * 16 * 80 * 80;
        bf16_t* dst = (bf16_t*)(wl + WL_WG);
        for (int i = gt; i < 2 * R_ * (R_ / 8); i += NGT) {
            const int row = i / (R_ / 8), k8 = (i % (R_ / 8)) * 8;
            const int t = row >> 8, w = row & 255; const bool isI = w >= 128; const int rho = w & 31, p32 = 8 * ((rho & 15) >> 2) + 4 * (rho >> 4) + (rho & 3);
            const int c = t * 128 + ((w & 127) & ~31) + p32, h = c / 80, j = c % 80;
            const float* src = (isI ? wx : wa) + (size_t)h * 80 * 80 + j;
            float v[8];
#pragma unroll
            for (int e = 0; e < 8; ++e) { const int k = k8 + e, ki = k - h * 80; v[e] = (ki >= 0 && ki < 80) ? src[ki * 80] : 0.f; }
            u32x4 o; o.x = pk2(v[0], v[1]); o.y = pk2(v[2], v[3]); o.z = pk2(v[4], v[5]); o.w = pk2(v[6], v[7]);
            *(u32x4*)(dst + (size_t)row * R_ + k8) = o;
        }
    }
}

__device__ __forceinline__ void prep_global(PLp P, LAS unsigned char* lds, int G) {
    P = opaque_pl();
    const int tid = opaque_tid(), lane = tid & 63, wave = __builtin_amdgcn_readfirstlane(tid >> 6); G = opaque_s(G); const int bid = opaque_bid();
    LAS float* scr = (LAS float*)(lds + wave * 8448);
    const int gw = bid * NWAVES + wave, NGW = G * NWAVES;
    bf16_t* wpp = (bf16_t*)(P->ws + OFF_WPPALL);
    constexpr int I_PPt = (PLE_ / 16) * (D_ / 256);
    for (int it = gw; it < 4 * I_PPt; it += NGW) {
        const int l = it / I_PPt, r = it % I_PPt;
        const int K = opaque_s(PLE_), N = opaque_s(D_);
        tr_item(P->in[I_PLP] + (size_t)l * PLE_ * D_, K, N, wpp + l * PLE_, D_, 0, 0, nullptr, r, lane);
    }
    const int gt = bid * NTHR + tid, NGT = G * NTHR;
    const float* src = P->in[I_P]; bf16_t* dst = (bf16_t*)(P->ws + OFF_PBALL);
    constexpr int NP8 = 4 * M_ * (PLE_ / 8);
    for (int i0 = gt; i0 < NP8; i0 += 8 * NGT) {
        f32x4 a[8], b[8];
#pragma unroll
        for (int u = 0; u < 8; ++u) { const int i = i0 + u * NGT; if (i < NP8) { a[u] = __builtin_nontemporal_load((const f32x4*)(src + (size_t)i * 8)); b[u] = __builtin_nontemporal_load((const f32x4*)(src + (size_t)i * 8 + 4)); } }
#pragma unroll
        for (int u = 0; u < 8; ++u) { const int i = i0 + u * NGT; if (i < NP8) {
            const int l = i / (M_ * (PLE_ / 8)), rem = i % (M_ * (PLE_ / 8)), row = rem / (PLE_ / 8), c8 = (rem % (PLE_ / 8)) * 8;
            u32x4 o; o.x = pk2(a[u][0], a[u][1]); o.y = pk2(a[u][2], a[u][3]); o.z = pk2(b[u][0], b[u][1]); o.w = pk2(b[u][2], b[u][3]);
            *(u32x4*)(dst + (size_t)row * D_ + l * PLE_ + c8) = o; } }
    }
}

__device__ __forceinline__ void init_phase(PLp P, int G) {
    P = opaque_pl();
    const int tid = opaque_tid(), lane = tid & 63, wave = tid >> 6; G = opaque_s(G); const int bid = opaque_bid();
    const int gw = bid * NWAVES + wave, NGW = G * NWAVES;
    float* ss = (float*)(P->ws + OFF_SS);
    bf16_t* hb = (bf16_t*)(P->ws + OFF_HB0);
    for (int row = gw; row < M_; row += 4 * NGW) {
        f32x4 v[4][4];
#pragma unroll
        for (int r = 0; r < 4; ++r) { const int rr = row + r * NGW; if (rr < M_) { const f32x4* xr = (const f32x4*)(P->in[I_X] + (size_t)rr * D_) + lane;
#pragma unroll
            for (int j = 0; j < 4; ++j) v[r][j] = __builtin_nontemporal_load(xr + 64 * j); } }
#pragma unroll
        for (int r = 0; r < 4; ++r) { const int rr = row + r * NGW; if (rr < M_) {
            u32x2* o8 = (u32x2*)(hb + (size_t)rr * D_) + lane; float s = 0.f;
#pragma unroll
            for (int j = 0; j < 4; ++j) { s += (v[r][j][0] * v[r][j][0] + v[r][j][1] * v[r][j][1]) + (v[r][j][2] * v[r][j][2] + v[r][j][3] * v[r][j][3]); u32x2 q; q.x = pk2(v[r][j][0], v[r][j][1]); q.y = pk2(v[r][j][2], v[r][j][3]); o8[64 * j] = q; }
            s = wave_sum(s);
            if (lane == 0) ((u64*)ss)[rr] = (u64)(s * SS_FX); } }
    }
    const int gt = bid * NTHR + tid, NGT = G * NTHR;
    for (int i = gt; i < 16 * M_ / 2; i += NGT) *(f32x4*)(ss + 2 * SS_STRIDE + (size_t)i * 4) = zero4();
}

__device__ __forceinline__ void final_phase(PLp P, int G) {
    P = opaque_pl();
    const int tid = opaque_tid(), lane = tid & 63, wave = tid >> 6; G = opaque_s(G);
    const int gw = opaque_bid() * NWAVES + wave, NGW = G * NWAVES;
    const float* ss = (const float*)(P->ws + OFF_SS) + 2 * 16 * SS_STRIDE;
    const f32x4* fn = (const f32x4*)P->in[I_FN] + lane;
    const bf16_t* hb1 = (const bf16_t*)(P->ws + OFF_R2);
    for (int row = gw; row < M_; row += NGW) {
        f32x4* xr = (f32x4*)(P->out + (size_t)row * D_) + lane;
        const u32x2* hr = (const u32x2*)(hb1 + (size_t)row * D_) + lane;
        const float rs = rsqrtf(ss_get(ss, row) * (1.0f / D_) + EPS_);
#pragma unroll
        for (int j = 0; j < 4; ++j) { const u32x2 hw = __builtin_nontemporal_load(hr + 64 * j); __builtin_nontemporal_store((f32x4){bf_lo(hw.x), bf_hi(hw.x), bf_lo(hw.y), bf_hi(hw.y)} * rs * fn[64 * j], xr + 64 * j); }
    }
}

__device__ __forceinline__ void conv_phase(PLp P, int jl, int G) {
    P = opaque_pl();
    G = opaque_s(G); const int tid = opaque_tid();
    const bf16_t* Z = (const bf16_t*)(P->ws + OFF_R1); bf16_t* XCb = (bf16_t*)(P->ws + OFF_R4);
    const float* cw = P->in[I_LCW] + (size_t)jl * 4 * R_; const float* cb = P->in[I_LCB] + (size_t)jl * R_;
    if (tid >= 320) return;
    const int c8 = (tid % 160) * 8, tg = tid / 160;
    float w[4][8], bb[8];
#pragma unroll
    for (int k = 0; k < 4; ++k) { const f32x4 a = *(const f32x4*)(cw + k * R_ + c8), b = *(const f32x4*)(cw + k * R_ + c8 + 4);
#pragma unroll
        for (int j = 0; j < 4; ++j) { w[k][j] = a[j]; w[k][4 + j] = b[j]; } }
    { const f32x4 a = *(const f32x4*)(cb + c8), b = *(const f32x4*)(cb + c8 + 4);
#pragma unroll
        for (int j = 0; j < 4; ++j) { bb[j] = a[j]; bb[4 + j] = b[j]; } }
    for (int it = opaque_bid(); it < M_ / 64; it += G) {
        const int row0 = it * 64 + tg * 32;
        float x3[8], x2[8], x1[8];
        u32x4 p3 = (u32x4){0u, 0u, 0u, 0u}, p2 = p3, p1 = p3;
        if ((row0 & (S_ - 1)) != 0) { p3 = *(const u32x4*)(Z + (size_t)(row0 - 3) * (2 * R_) + R_ + c8); p2 = *(const u32x4*)(Z + (size_t)(row0 - 2) * (2 * R_) + R_ + c8); p1 = *(const u32x4*)(Z + (size_t)(row0 - 1) * (2 * R_) + R_ + c8); }
#pragma unroll
        for (int j = 0; j < 4; ++j) { x3[2 * j] = bf_lo(p3[j]); x3[2 * j + 1] = bf_hi(p3[j]); x2[2 * j] = bf_lo(p2[j]); x2[2 * j + 1] = bf_hi(p2[j]); x1[2 * j] = bf_lo(p1[j]); x1[2 * j + 1] = bf_hi(p1[j]); }
#pragma unroll 8
        for (int t = 0; t < 32; ++t) {
            const u32x4 px = __builtin_nontemporal_load((const u32x4*)(Z + (size_t)(row0 + t) * (2 * R_) + R_ + c8));
            float x0[8], o[8];
#pragma unroll
            for (int j = 0; j < 4; ++j) { x0[2 * j] = bf_lo(px[j]); x0[2 * j + 1] = bf_hi(px[j]); }
#pragma unroll
            for (int j = 0; j < 8; ++j) { o[j] = bb[j] + w[0][j] * x3[j] + w[1][j] * x2[j] + w[2][j] * x1[j] + w[3][j] * x0[j]; x3[j] = x2[j]; x2[j] = x1[j]; x1[j] = x0[j]; }
            u32x4 q; q.x = pk2(o[0], o[1]); q.y = pk2(o[2], o[3]); q.z = pk2(o[4], o[5]); q.w = pk2(o[6], o[7]);
            *(u32x4*)(XCb + (size_t)(row0 + t) * R_ + c8) = q;
        }
    }
}

__device__ __forceinline__ void scan1_phase(PLp P, int G) {
    P = opaque_pl();
    G = opaque_s(G); const int tid = opaque_tid();
    const bf16_t* LA = (const bf16_t*)(P->ws + OFF_R2); const bf16_t* Bb = LA + (size_t)M_ * R_;
    float* aggP = (float*)(P->ws + OFF_AGG); float* aggH = aggP + AGG_ELEMS;
    if (tid >= 320) return;
    const int c4 = tid * 4;
    for (int bc = opaque_bid(); bc < 256; bc += G) {
        const size_t base = (size_t)bc * 64 * R_ + c4;
        f32x4 h = zero4(), sl = h;
#pragma unroll 16
        for (int t = 0; t < 64; ++t) {
            const u32x2 lw = *(const u32x2*)(LA + base + (size_t)t * R_), bw = *(const u32x2*)(Bb + base + (size_t)t * R_);
            const f32x4 la = (f32x4){bf_lo(lw.x), bf_hi(lw.x), bf_lo(lw.y), bf_hi(lw.y)}, b = (f32x4){bf_lo(bw.x), bf_hi(bw.x), bf_lo(bw.y), bf_hi(bw.y)};
            f32x4 a; a[0] = __expf(la[0]); a[1] = __expf(la[1]); a[2] = __expf(la[2]); a[3] = __expf(la[3]);
            h = a * h + b; sl += la;
        }
        f32x4 p; p[0] = __expf(sl[0]); p[1] = __expf(sl[1]); p[2] = __expf(sl[2]); p[3] = __expf(sl[3]);
        *(f32x4*)(aggP + (size_t)bc * R_ + c4) = p; *(f32x4*)(aggH + (size_t)bc * R_ + c4) = h;
    }
}
__device__ __forceinline__ void scan2_phase(PLp P, int G) {
    P = opaque_pl();
    G = opaque_s(G); const int tid = opaque_tid();
    const bf16_t* LA = (const bf16_t*)(P->ws + OFF_R2); const bf16_t* Bb = LA + (size_t)M_ * R_;
    const float* aggP = (const float*)(P->ws + OFF_AGG); const float* aggH = aggP + AGG_ELEMS;
    const bf16_t* Z = (const bf16_t*)(P->ws + OFF_R1); bf16_t* Y = (bf16_t*)(P->ws + OFF_R5);
    if (tid >= 320) return;
    const int c4 = tid * 4;
    for (int bc = opaque_bid(); bc < 256; bc += G) {
        const int chunk = bc & 127, b0 = bc - chunk;
        f32x4 h = zero4();
#pragma unroll 8
        for (int j = 0; j < chunk; ++j) { const f32x4 a = *(const f32x4*)(aggP + (size_t)(b0 + j) * R_ + c4), b = *(const f32x4*)(aggH + (size_t)(b0 + j) * R_ + c4); h = a * h + b; }
        const size_t base = (size_t)bc * 64 * R_ + c4;
#pragma unroll 8
        for (int t = 0; t < 64; ++t) {
            const size_t idx = base + (size_t)t * R_;
            const u32x2 lw = __builtin_nontemporal_load((const u32x2*)(LA + idx)), bw = __builtin_nontemporal_load((const u32x2*)(Bb + idx));
            const u32x2 gw = __builtin_nontemporal_load((const u32x2*)(Z + ((size_t)bc * 64 + t) * (2 * R_) + c4));
            const f32x4 la = (f32x4){bf_lo(lw.x), bf_hi(lw.x), bf_lo(lw.y), bf_hi(lw.y)}, b = (f32x4){bf_lo(bw.x), bf_hi(bw.x), bf_lo(bw.y), bf_hi(bw.y)};
            f32x4 a; a[0] = __expf(la[0]); a[1] = __expf(la[1]); a[2] = __expf(la[2]); a[3] = __expf(la[3]);
            h = a * h + b;
            u32x2 y; y.x = pk2(h[0] * bf_lo(gw.x), h[1] * bf_hi(gw.x)); y.y = pk2(h[2] * bf_lo(gw.y), h[3] * bf_hi(gw.y));
            *(u32x2*)(Y + idx) = y;
        }
    }
}

__device__ __forceinline__ void pool_prep_phase(PLp P, int layer, LAS unsigned char* lds, int G) {
    P = opaque_pl();
    const int tid = opaque_tid(); G = opaque_s(G);
    const bf16_t* h = (const bf16_t*)(P->ws + OFF_HB0); const float* ss = (const float*)(P->ws + OFF_SS) + (size_t)(4 * layer + 1) * SS_STRIDE * 2;
    bf16_t* U = (bf16_t*)(P->ws + OFF_R1);
    LAS float* T = (LAS float*)lds;
    for (int it = opaque_bid(); it < 1024; it += G) {
        const int tt = it >> 2, g = it & 3, W = 2 << g, base = tt * 64, tl0 = base & (S_ - 1);
        {
            const int c4 = tid & 63, rq = tid >> 6;
            u32x2 hw[10]; float rsr[10];
#pragma unroll
            for (int j = 0; j < 10; ++j) {
                const int s = 16 - W + rq + 8 * j, rel = s - 15;
                hw[j] = (u32x2){0u, 0u}; rsr[j] = 0.f;
                if (s < 79 && tl0 + rel >= 0) { const int row = base + rel; hw[j] = *(const u32x2*)(h + (size_t)row * D_ + g * 256 + c4 * 4); rsr[j] = ss_get(ss, row); }
            }
#pragma unroll
            for (int j = 0; j < 10; ++j) {
                const int s = 16 - W + rq + 8 * j;
                if (s < 79) { const float rs = rsqrtf(rsr[j] * (1.0f / D_) + EPS_);
                    *(LAS f32x4*)(T + s * 256 + c4 * 4) = (f32x4){bf_lo(hw[j].x), bf_hi(hw[j].x), bf_lo(hw[j].y), bf_hi(hw[j].y)} * rs; }
            }
        }
        __syncthreads();
        {
            const int c4 = tid & 63, tq = tid >> 6;
#pragma unroll 2
            for (int j = 0; j < 8; ++j) {
                const int tl = tq + 8 * j, tloc = tl0 + tl;
                const int cnt = (tloc + 1 < W) ? (tloc + 1) : W;
                const f32x4 cur = *(const LAS f32x4*)(T + (tl + 15) * 256 + c4 * 4);
                f32x4 sum = cur;
                for (int s = 1; s < W; ++s) sum += *(const LAS f32x4*)(T + (tl + 15 - s) * 256 + c4 * 4);
                const f32x4 u = sum * (1.0f / (float)cnt) - cur;
                u32x2 w; w.x = pk2(u[0], u[1]); w.y = pk2(u[2], u[3]);
                *(u32x2*)(U + (size_t)(base + tl) * D_ + g * 256 + c4 * 4) = w;
            }
        }
        __syncthreads();
    }
}

__device__ __forceinline__ void build_table(PLp PL, LAS GemmDesc* tab) {
    unsigned char* ws = PL->ws; float* out = PL->out;
    float* SS = (float*)(ws + OFF_SS);
    bf16_t* HB0 = (bf16_t*)(ws + OFF_HB0);
    bf16_t* HB1 = (bf16_t*)(ws + OFF_R2);
    for (int step = 0; step < 40; ++step) {
        int layer, s, op;
        if (step >= 36) { layer = step - 36; op = 10; }
        else {
            if (step < 11) { layer = 0; s = step; } else if (step < 18) { layer = 1; s = step - 11; } else if (step < 29) { layer = 2; s = step - 18; } else { layer = 3; s = step - 29; }
            if (layer & 1) op = (s < 2) ? s : (s < 4 ? s + 10 : (s < 6 ? s + 4 : 11));
            else op = (s < 10) ? s : 11;
        }
        const int jl = layer >> 1;
        unsigned char* wl = ws + ((layer & 1) ? OFF_WL1 : OFF_WL0);
        LAS GemmDesc& d = tab[step];
        d.op = op; d.layer = layer; d.n2 = 0; d.daddr2 = 0;
        d.A = nullptr; d.Bt = nullptr; d.lda = 0; d.ldb = 0; d.nN = 0; d.nt = 0; d.emode = 0;
        d.nM = M_ / 256; d.kmode = 0; d.sub = 0; d.alpha = 1.0f;
        d.ss = nullptr; d.o16 = nullptr; d.o32 = nullptr; d.hsrc = nullptr; d.ssn = nullptr; d.v0 = nullptr; d.v1 = nullptr; d.v2 = nullptr; d.pp = nullptr; d.o16b = nullptr;
        if (op == 0 || op == 8) {
            const bool first = (op == 0);
            d.A = first ? (layer == 0 ? HB0 : HB1) : HB0; d.lda = D_;
            d.Bt = (const bf16_t*)(wl + (first ? WL_GU1 : WL_GU2)); d.ldb = D_; d.nN = 2 * F_ / 256; d.nt = D_ / 64;
            d.emode = E_GU; d.ss = SS + (size_t)(4 * layer + (first ? 0 : 2)) * SS_STRIDE * 2; d.o16 = (bf16_t*)(ws + OFF_R1);
            if (!first) { d.n2 = (M_ / 256) * (D_ / 256); d.daddr2 = LDS_DL + (36 + layer) * DESC_BYTES; }
        } else if (op == 1 || op == 9) {
            const bool first = (op == 1);
            d.A = (const bf16_t*)(ws + OFF_R1); d.lda = F_;
            d.Bt = (const bf16_t*)(wl + (first ? WL_D1 : WL_D2)); d.ldb = F_; d.nN = D_ / 256; d.nt = F_ / 64;
            d.emode = E_RESID; d.sub = 0; d.alpha = 0.5f;
            d.hsrc = (const float*)((first && layer > 0) ? HB1 : HB0); d.o16 = HB0;
            d.ssn = SS + (size_t)(4 * layer + (first ? 1 : 3)) * SS_STRIDE * 2;
        } else if (op == 2) {
            d.A = HB0; d.lda = D_; d.Bt = (const bf16_t*)(wl + WL_WIN); d.ldb = D_; d.nN = 2 * R_ / 256; d.nt = D_ / 64;
            d.emode = E_WIN; d.ss = SS + (size_t)(4 * layer + 1) * SS_STRIDE * 2; d.o16 = (bf16_t*)(ws + OFF_R1);
        } else if (op == 4) {
            d.A = (const bf16_t*)(ws + OFF_R4); d.lda = R_; d.Bt = (const bf16_t*)(wl + WL_WG); d.ldb = R_; d.nN = 2 * R_ / 256; d.nt = 0; d.kmode = 2;
            d.emode = E_GATES; d.v0 = PL->in[I_LBA] + (size_t)jl * R_; d.v1 = PL->in[I_LBX] + (size_t)jl * R_; d.v2 = PL->in[I_LAP] + (size_t)jl * R_;
            d.pp = (const bf16_t*)(ws + OFF_R4); d.o16 = (bf16_t*)(ws + OFF_R2); d.o16b = (bf16_t*)(ws + OFF_R2) + (size_t)M_ * R_;
        } else if (op == 7) {
            d.A = (const bf16_t*)(ws + OFF_R5); d.lda = R_; d.Bt = (const bf16_t*)(wl + WL_WOUT); d.ldb = R_; d.nN = D_ / 256; d.nt = R_ / 64;
            d.emode = E_RESID; d.sub = 0; d.alpha = 1.0f; d.hsrc = (const float*)HB0; d.o16 = HB0; d.ssn = SS + (size_t)(4 * layer + 2) * SS_STRIDE * 2;
        } else if (op == 13) {
            d.A = (const bf16_t*)(ws + OFF_R1); d.lda = D_; d.Bt = (const bf16_t*)(wl + WL_MIX); d.ldb = D_; d.nN = D_ / 256; d.nt = 4; d.kmode = 1;
            d.emode = E_RESID; d.sub = 1; d.v0 = PL->in[I_PB] + (size_t)jl * D_; d.v1 = PL->in[I_PS] + (size_t)jl * D_;
            d.hsrc = (const float*)HB0; d.o16 = HB0; d.ssn = SS + (size_t)(4 * layer + 2) * SS_STRIDE * 2;
        } else if (op == 10) {
            d.A = (const bf16_t*)(ws + OFF_PBALL) + layer * PLE_; d.lda = D_; d.Bt = (const bf16_t*)(ws + OFF_WPPALL) + layer * PLE_; d.ldb = D_; d.nN = D_ / 256; d.nt = PLE_ / 64;
            d.emode = E_PROJ; d.o16 = (bf16_t*)(ws + OFF_R4);
        } else if (op == 11) {
            d.A = HB0; d.lda = D_; d.Bt = (const bf16_t*)(wl + WL_PG); d.ldb = D_; d.nN = D_ / 256; d.nt = D_ / 64;
            d.emode = E_RESID; d.sub = 2; d.ss = SS + (size_t)(4 * layer + 3) * SS_STRIDE * 2; d.pp = (const bf16_t*)(ws + OFF_R4);
            d.hsrc = (const float*)HB0; d.o16 = HB1; d.ssn = SS + (size_t)(4 * layer + 4) * SS_STRIDE * 2;
        }
    }
}

__global__ void __launch_bounds__(NTHR, 2) fwd_megakernel(Params P) {
    extern __shared__ __attribute__((aligned(16))) unsigned char lds_raw[];
    LAS unsigned char* lds = (LAS unsigned char*)lds_raw;
    const int tid = threadIdx.x, G = gridDim.x;
    volatile LAS unsigned* st = (volatile LAS unsigned*)(lds + LDS_STAGE);
    LAS Params* PLw = (LAS Params*)(lds + LDS_PL);
    static_assert(sizeof(Params) <= 256 && sizeof(GemmDesc) == DESC_BYTES, "lds ctl");
    if (tid == 0) {
        st[0] = 0u; st[1] = 0u; st[2] = 0u; st[3] = 0u;
#pragma unroll
        for (int i = 0; i < 27; ++i) PLw->in[i] = P.in[i];
        PLw->out = P.out; PLw->ws = P.ws; PLw->lo = P.lo; PLw->hi = P.hi;
        build_table((PLp)PLw, (LAS GemmDesc*)(lds + LDS_DL));
    }
    __syncthreads();
    PLp PL = (PLp)PLw;
    const int lo = P.lo, hi = P.hi;
#if ONE_LAUNCH
    xcd_barrier_post((unsigned*)(P.ws + OFF_CTL), st);
    __syncthreads();
#endif

    unsigned long long tacc = 0, t0 = 0;
#define T_BEGIN() do { if (TMASK) t0 = __builtin_amdgcn_s_memrealtime(); } while (0)
#define T_END(bit) do { if ((TMASK >> (bit)) & 1) tacc += __builtin_amdgcn_s_memrealtime() - t0; } while (0)
    for (int step = lo; step < hi; ++step) {
        if (step == -1) {
            T_BEGIN();
            init_phase(PL, G);
            prep_global(PL, lds, G);
            prep_layer(PL, 0, OFF_WL0, lds, (int)blockIdx.x, G, 2);
            T_END(14);
#if ONE_LAUNCH
            cg::this_grid().sync();
#endif
            continue;
        }
        if (step == 36) { T_BEGIN(); final_phase(PL, G); T_END(15);
            if (TMASK && blockIdx.x == TBLK) { asm volatile("s_waitcnt vmcnt(0)" ::: "memory"); const unsigned long long ts = __builtin_amdgcn_s_memrealtime(); while (__builtin_amdgcn_s_memrealtime() - ts < tacc * TMULT) __builtin_amdgcn_s_sleep(8); }
            continue; }
        const int daddr = LDS_DL + step * DESC_BYTES;
        DescP dd = opaque_desc(daddr);
        const int op = rfl(dd->op), layer = rfl(dd->layer);
        T_BEGIN();
        if (op == 3) conv_phase(PL, layer >> 1, G);
        else if (op == 5) scan1_phase(PL, G);
        else if (op == 6) scan2_phase(PL, G);
        else if (op == 12) pool_prep_phase(PL, layer, lds, G);
        else {
            { unsigned long long tk = 0; gemm_phase(lds, daddr, G, (int)blockIdx.x, tk); if (((TMASK >> 18) & 1) && ((TMASK >> op) & 1)) tacc += ((TMASK >> 19) & 1) ? tk / 20 : tk; }
            if (TMASK) { if (((TMASK >> op) & 1) && !((TMASK >> 18) & 1)) tacc += __builtin_amdgcn_s_memrealtime() - t0; T_BEGIN(); }
            if ((op == 0 || op == 8) && layer < 3) {
                const int tot = (M_ / 256) * (2 * F_ / 256) + (op == 8 ? (M_ / 256) * (D_ / 256) : 0), rem = tot % G;
                if ((int)blockIdx.x >= rem) prep_layer(PL, layer + 1, ((layer + 1) & 1) ? OFF_WL1 : OFF_WL0, lds, (int)blockIdx.x - rem, G - rem, op == 8 ? 1 : 0);
                T_END(17); T_BEGIN();
            }
        }
        if (TMASK) { if (op == 3 || op == 5 || op == 6 || op == 12) { if ((TMASK >> op) & 1) tacc += __builtin_amdgcn_s_memrealtime() - t0; } T_BEGIN(); }
#if ONE_LAUNCH
        xcd_barrier(st);
#endif
        T_END(16);
    }
}

extern "C" void kernel_launch(void* const* d_in, const int* in_sizes, int n_in, void* d_out, int out_size, void* d_ws, size_t ws_size, hipStream_t stream) {
    static int grid = 0;
    if (grid == 0) {
        if (n_in != 27 || out_size != M_ * D_ || ws_size < WS_END) { fprintf(stderr, "kernel_launch: bad shapes n_in %d out %d ws %zu (need %zu)\n", n_in, out_size, ws_size, (size_t)WS_END); grid = -1; return; }
        int dev = 0, cus = 0, per_cu = 0;
        hipGetDevice(&dev); hipDeviceGetAttribute(&cus, hipDeviceAttributeMultiprocessorCount, dev);
        if (hipFuncSetAttribute((const void*)fwd_megakernel, hipFuncAttributeMaxDynamicSharedMemorySize, LDS_BYTES) != hipSuccess) { fprintf(stderr, "kernel_launch: hipFuncSetAttribute failed\n"); grid = -1; return; }
        hipOccupancyMaxActiveBlocksPerMultiprocessor(&per_cu, (const void*)fwd_megakernel, NTHR, LDS_BYTES);
        (void)hipGetLastError();
        if (per_cu < 1) fprintf(stderr, "kernel_launch: occupancy query reports %d blocks per CU\n", per_cu);
        grid = cus;
    }
    if (grid < 0) return;
    hipMemsetAsync((char*)d_ws + OFF_CTL, 0, 16384, stream);
    Params p{};
    for (int i = 0; i < 27; ++i) p.in[i] = (const float*)d_in[i];
    p.out = (float*)d_out; p.ws = (unsigned char*)d_ws;
#if ONE_LAUNCH
    p.lo = -1; p.hi = 37;
    void* args[] = {&p};
    hipError_t e = hipLaunchCooperativeKernel((const void*)fwd_megakernel, dim3(grid), dim3(NTHR), args, LDS_BYTES, stream);
    if (e != hipSuccess) fprintf(stderr, "cooperative launch failed: %s (grid %d)\n", hipGetErrorString(e), grid);
#else
    for (int s = -1; s < 37; ++s) { p.lo = s; p.hi = s + 1; hipLaunchKernelGGL(fwd_megakernel, dim3(grid), dim3(NTHR), LDS_BYTES, stream, p); }
#endif
}
```
